# Optimizing an MI355X kernel written in HIP

```python
import jax, jax.numpy as jnp
from jax import lax
import numpy as np

D_MODEL = 1024
BATCH = 2
SEQ = 8192
DEPTH = 1

PLE_DIM = 256
D_CONV = 512
CONV_A_WIDTH = 3
N_HEADS = 4
HEAD_K = 128
HEAD_V = 128
D_DN_K = N_HEADS * HEAD_K
D_DN_V = N_HEADS * HEAD_V
CONV_DN_WIDTH = 3
CHUNK = 64
D_FF = 4 * D_MODEL
EPS = 1e-6

SPLITS = (D_CONV, D_CONV, D_CONV, 2 * D_DN_K + D_DN_V, D_DN_V,
          N_HEADS, N_HEADS, N_HEADS, N_HEADS, D_MODEL, D_MODEL)
D_IN_PROJ = sum(SPLITS)

kernel_name = "hybrid_gated_conv_deltanet_encoder_block"


def _split_points():
    pts, acc = [], 0
    for w in SPLITS[:-1]:
        acc += w
        pts.append(acc)
    return pts


def rms_norm(x, g):
    xf = x.astype(jnp.float32)
    y = xf * lax.rsqrt(jnp.mean(xf * xf, axis=-1, keepdims=True) + EPS)
    return (y * g.astype(jnp.float32)).astype(x.dtype)


def l2_norm(x):
    return x * lax.rsqrt(jnp.sum(x * x, axis=-1, keepdims=True) + EPS)


def dwconv_centred(x, w):
    k = w.shape[0]
    r = k // 2
    s = x.shape[1]
    xp = jnp.pad(x, ((0, 0), (r, r), (0, 0)))
    return sum(xp[:, j:j + s, :] * w[j] for j in range(k))


def gated_delta_rule(q, k, v, g, beta):
    b, s, h, dk = q.shape
    dv = v.shape[-1]
    n = s // CHUNK

    def chunks(t):
        return t.reshape(b, n, CHUNK, h, -1).transpose(0, 3, 1, 2, 4)

    q, k, v = chunks(q), chunks(k), chunks(v)
    g = jnp.cumsum(g.reshape(b, n, CHUNK, h).transpose(0, 3, 1, 2), axis=-1)
    beta = beta.reshape(b, n, CHUNK, h).transpose(0, 3, 1, 2)

    tri = jnp.tril(jnp.ones((CHUNK, CHUNK), dtype=bool))
    strict = jnp.tril(jnp.ones((CHUNK, CHUNK), dtype=bool), -1)
    decay = jnp.exp(jnp.where(tri, g[..., :, None] - g[..., None, :], -jnp.inf))

    kb = k * beta[..., None]
    vb = v * beta[..., None]
    a = jnp.where(strict, jnp.einsum('bhncd,bhnjd->bhncj', kb, k) * decay, 0.0)
    eye = jnp.eye(CHUNK, dtype=jnp.float32)
    t_inv = lax.linalg.triangular_solve(eye + a, jnp.broadcast_to(eye, a.shape),
                                        left_side=True, lower=True, unit_diagonal=True)
    u = t_inv @ vb
    w = t_inv @ (kb * jnp.exp(g)[..., None])
    intra = jnp.einsum('bhncd,bhnjd->bhncj', q, k) * decay

    def step(state, inp):
        q_c, k_c, u_c, w_c, g_c, a_c = inp
        v_new = u_c - w_c @ state
        o = (q_c * jnp.exp(g_c)[..., None]) @ state + a_c @ v_new
        g_last = g_c[..., -1]
        state = state * jnp.exp(g_last)[..., None, None] + jnp.einsum(
            'bhcd,bhce->bhde', k_c * jnp.exp(g_last[..., None] - g_c)[..., None], v_new)
        return state, o

    xs = tuple(jnp.moveaxis(t, 2, 0) for t in (q, k, u, w, g, intra))
    state0 = jnp.zeros((b, h, dk, dv), jnp.float32)
    _, o = lax.scan(step, state0, xs)
    return o.transpose(1, 0, 3, 2, 4).reshape(b, s, h, dv)


def setup_inputs(seed: int = 0) -> dict:
    key = jax.random.key(seed)
    ks = jax.random.split(key, 24)
    L = DEPTH
    f32 = jnp.float32

    def dense(k, fan_in, fan_out):
        return jax.random.normal(k, (L, fan_in, fan_out), f32) * fan_in ** -0.5

    def gain(k, n):
        return 1.0 + 0.02 * jax.random.normal(k, (L, n), f32)

    a_log_f = jnp.log(jax.random.uniform(ks[5], (L, N_HEADS), f32, 1.0, 16.0))
    a_log_b = jnp.log(jax.random.uniform(ks[6], (L, N_HEADS), f32, 1.0, 16.0))

    def dt_bias(k):
        u = jax.random.uniform(k, (L, N_HEADS), f32)
        dt = jnp.exp(u * (jnp.log(0.1) - jnp.log(0.001)) + jnp.log(0.001))
        return dt + jnp.log(-jnp.expm1(-dt))

    return {
        "x": jax.random.normal(ks[0], (BATCH, SEQ, D_MODEL), f32),
        "p": jax.random.normal(ks[1], (DEPTH, BATCH, SEQ, PLE_DIM), f32),
        "g_mix": gain(ks[2], D_MODEL),
        "w_in": dense(ks[3], D_MODEL, D_IN_PROJ),
        "conv_a": jax.random.normal(ks[4], (L, CONV_A_WIDTH, D_CONV), f32) * CONV_A_WIDTH ** -0.5,
        "conv_qkv": jax.random.normal(ks[7], (L, CONV_DN_WIDTH, 2 * D_DN_K + D_DN_V), f32) * CONV_DN_WIDTH ** -0.5,
        "a_log_f": a_log_f,
        "a_log_b": a_log_b,
        "dt_bias_f": dt_bias(ks[8]),
        "dt_bias_b": dt_bias(ks[9]),
        "g_dn_norm": gain(ks[10], HEAD_V),
        "w_a_out": dense(ks[11], D_CONV, D_MODEL),
        "w_dn_out": dense(ks[12], D_DN_V, D_MODEL),
        "w_o": dense(ks[13], D_MODEL, D_MODEL),
        "g_ffn": gain(ks[14], D_MODEL),
        "w_ff1": dense(ks[15], D_MODEL, D_FF),
        "w_ff2": dense(ks[16], D_FF, D_MODEL),
        "g_ple": gain(ks[17], D_MODEL),
        "w_ple_gate": dense(ks[18], D_MODEL, D_MODEL),
        "w_ple_proj": dense(ks[19], PLE_DIM, D_MODEL),
        "g_final": 1.0 + 0.02 * jax.random.normal(ks[20], (D_MODEL,), f32),
    }


def reference(x, p, g_mix, w_in, conv_a, conv_qkv, a_log_f, a_log_b, dt_bias_f, dt_bias_b,
              g_dn_norm, w_a_out, w_dn_out, w_o, g_ffn, w_ff1, w_ff2, g_ple, w_ple_gate,
              w_ple_proj, g_final):
    b, s, _ = x.shape
    f32 = jnp.float32
    h = x
    for i in range(DEPTH):
        n = rms_norm(h, g_mix[i])
        proj = n @ w_in[i]
        (b_a, c_a, x_a, qkv, z, beta_f, beta_b, alpha_f, alpha_b,
         gate_a, gate_dn) = jnp.split(proj, _split_points(), axis=-1)

        y_a = c_a * dwconv_centred(b_a * x_a, conv_a[i])

        qkv = jax.nn.silu(dwconv_centred(qkv, conv_qkv[i]))
        q, k, v = jnp.split(qkv, [D_DN_K, 2 * D_DN_K], axis=-1)
        q = l2_norm(q.reshape(b, s, N_HEADS, HEAD_K).astype(f32)) * HEAD_K ** -0.5
        k = l2_norm(k.reshape(b, s, N_HEADS, HEAD_K).astype(f32))
        v = v.reshape(b, s, N_HEADS, HEAD_V).astype(f32)
        g_f = -jnp.exp(a_log_f[i].astype(f32)) * jax.nn.softplus(alpha_f.astype(f32) + dt_bias_f[i].astype(f32))
        g_b = -jnp.exp(a_log_b[i].astype(f32)) * jax.nn.softplus(alpha_b.astype(f32) + dt_bias_b[i].astype(f32))
        bt_f = jax.nn.sigmoid(beta_f.astype(f32))
        bt_b = jax.nn.sigmoid(beta_b.astype(f32))
        flip = lambda t: jnp.flip(t, axis=1)
        o = gated_delta_rule(q, k, v, g_f, bt_f) + flip(
            gated_delta_rule(flip(q), flip(k), flip(v), flip(g_b), flip(bt_b)))
        o = rms_norm(o, g_dn_norm[i]) * jax.nn.silu(z.reshape(b, s, N_HEADS, HEAD_V).astype(f32))
        y_dn = o.reshape(b, s, D_DN_V).astype(h.dtype)

        merged = (jax.nn.sigmoid(gate_a) * (y_a @ w_a_out[i])
                  + jax.nn.sigmoid(gate_dn) * (y_dn @ w_dn_out[i]))
        h = h + merged @ w_o[i]

        n2 = rms_norm(h, g_ffn[i])
        h = h + jnp.square(jax.nn.relu(n2 @ w_ff1[i])) @ w_ff2[i]

        gate_p = jax.nn.sigmoid(rms_norm(h, g_ple[i]) @ w_ple_gate[i])
        h = h + gate_p * (p[i] @ w_ple_proj[i])
    return rms_norm(h, g_final)
```

```cpp
#include <hip/hip_runtime.h>
#include <hip/hip_cooperative_groups.h>
#include <cstdio>
#include <cstdint>
namespace cg = cooperative_groups;

#ifndef PROBE_PH
#define PROBE_PH -1
#endif
#ifndef PROBE_EXTRA
#define PROBE_EXTRA 0
#endif
#ifndef PROBE_SYNCS
#define PROBE_SYNCS 0
#endif
#ifndef MK_PER_PHASE
#define MK_PER_PHASE 0
#endif

#define DI __device__ __forceinline__
#define LAS __attribute__((address_space(3)))
#define GAS __attribute__((address_space(1)))
typedef unsigned short bf16_t;
typedef short bf16x8 __attribute__((ext_vector_type(8)));
typedef float f32x4 __attribute__((ext_vector_type(4)));
typedef float f32x2 __attribute__((ext_vector_type(2)));
typedef unsigned u32x4 __attribute__((ext_vector_type(4)));
typedef unsigned u32x2 __attribute__((ext_vector_type(2)));
typedef __bf16 bf16v2 __attribute__((ext_vector_type(2)));

constexpr int MTOK = 16384, DM = 1024, SEQ = 8192, NH = 4, DFF = 4096, PLE = 256;
constexpr float EPS = 1e-6f;
constexpr int NPROJ = 5888;
constexpr int LDS_BYTES = 147456;
constexpr int NPHASE = 13;

constexpr size_t OFF_RSS = 0;
constexpr size_t OFF_BAR = 196608;
constexpr size_t OFF_CNT = 212992;
constexpr size_t OFF_FLG = 221184;
constexpr size_t OFF_WIN = 262144;
constexpr size_t OFF_WAD = OFF_WIN + 12058624;
constexpr size_t OFF_WO = OFF_WAD + 2097152;
constexpr size_t OFF_W1 = OFF_WO + 2097152;
constexpr size_t OFF_W2 = OFF_W1 + 8388608;
constexpr size_t OFF_WPG = OFF_W2 + 8388608;
constexpr size_t OFF_WPP = OFF_WPG + 2097152;
constexpr size_t OFF_PB = OFF_WPP + 524288;
constexpr size_t OFF_SMALL = OFF_PB + 8388608;
constexpr size_t OFF_GB = OFF_SMALL + 1048576;
constexpr size_t ARENA = OFF_GB + 1048576;
constexpr size_t A_ZG = ARENA;
constexpr size_t A_XN = ARENA + 83886080;
constexpr size_t A_PROJA = ARENA + 117440512;
constexpr size_t A_KTT = A_XN;
constexpr size_t A_OPS = ARENA + 100663296;
constexpr size_t A_YDN = A_OPS;
constexpr size_t A_TMP = ARENA + 117440512;
constexpr size_t A_MERGED = ARENA + 184549376;
constexpr size_t A_H1B = ARENA;
constexpr size_t A_ACT = ARENA + 33554432;
constexpr size_t A_H2B = ARENA + 167772160;
constexpr size_t A_PP = ARENA;
constexpr size_t OFF_RING = OFF_PB;
constexpr int RING_R = 13, RING_SLOT = 6144;
constexpr size_t WS_NEED = 268435456;
constexpr int OPS_TASK = 58368;

struct Args {
    const float* in[21];
    float* out;
    unsigned char* ws;
    int ph_lo, ph_hi;
    int wv, pad_;
};

DI unsigned pk2(float a, float b) { f32x2 v = {a, b}; return __builtin_bit_cast(unsigned, __builtin_convertvector(v, bf16v2)); }
DI float bf_lo(unsigned u) { return __uint_as_float(u << 16); }
DI float bf_hi(unsigned u) { return __uint_as_float(u & 0xffff0000u); }
DI float wave_sum(float v) {
#pragma unroll
    for (int o = 1; o < 64; o <<= 1) v += __shfl_xor(v, o);
    return v;
}
DI float sigmoidf_(float v) { return __builtin_amdgcn_rcpf(1.0f + __expf(-v)); }
DI bf16x8 pack8(f32x4 a, f32x4 b) { u32x4 p = {pk2(a[0], a[1]), pk2(a[2], a[3]), pk2(b[0], b[1]), pk2(b[2], b[3])}; return __builtin_bit_cast(bf16x8, p); }
DI bf16x8 pack8r(f32x4 a, f32x4 b) { u32x4 p = {pk2(a[3], a[2]), pk2(a[1], a[0]), pk2(b[3], b[2]), pk2(b[1], b[0])}; return __builtin_bit_cast(bf16x8, p); }
#define MFMA16(a, b, c) __builtin_amdgcn_mfma_f32_16x16x32_bf16((a), (b), (c), 0, 0, 0)
#define LDS_WAIT() asm volatile("s_waitcnt lgkmcnt(0)" ::: "memory")
DI int olane() { int l = (int)__builtin_amdgcn_mbcnt_hi(~0u, __builtin_amdgcn_mbcnt_lo(~0u, 0u)); asm volatile("" : "+v"(l)); return l; }
DI int otid(int wv) { int t = wv * 64 + olane(); asm volatile("" : "+v"(t)); return t; }
DI int osg(int v) { asm volatile("" : "+s"(v)); return v; }

namespace pg8 {
constexpr int BM = 256, BK = 64, HALF = 128, HTB = HALF * BK * 2, STAGE_BYTES = 8 * HTB, NXCD = 8, WGM = 8;
DI int lds_byte(int r, int c) { const int st = (r >> 4) * 2 + (c >> 5), rr = r & 15, cc = c & 31, ob = rr * 64 + cc * 2; return st * 1024 + (ob ^ (((ob >> 9) & 1) << 5)); }
DI void stage_rc(int b, int& R, int& C) { const int st = b / 1024, sb = b % 1024, swz = sb ^ (((sb >> 9) & 1) << 5); R = (st >> 1) * 16 + swz / 64; C = (st & 1) * 32 + (swz % 64) / 2; }
DI int perm32(int rho) { const int n = rho >> 4, i = rho & 15; return 8 * (i >> 2) + 4 * n + (i & 3); }

struct Unit { int pm, pn; };
struct Gemm { const bf16_t* A; const bf16_t* A2; const bf16_t* Bt; const bf16_t* Bt2; int ld; int nt; int nth; int wv; };

struct StaticOrder {
    int nM, nN, nwg, G, c;
    DI void init(int M, int N, int G_, int c_) { nM = M / BM; nN = N / BM; nwg = nM * nN; G = G_; c = c_; }
    DI bool tile(long L, Unit& u) const {
        if (L >= nwg) return false;
        int wgid = (int)L; { const int q = nwg / NXCD, r = nwg % NXCD, xcd = wgid % NXCD, off = wgid / NXCD; wgid = (xcd < r ? xcd * (q + 1) : r * (q + 1) + (xcd - r) * q) + off; }
        const int nig = WGM * nN, gid = wgid / nig, fm = gid * WGM, gsz = (nM - fm) < WGM ? (nM - fm) : WGM;
        u.pm = fm + ((wgid % nig) % gsz); u.pn = (wgid % nig) / gsz; return true;
    }
    DI bool next(int i, Unit& u) const { return tile((long)i * G + c, u); }
};
template <class Epi, class Sched>
DI void gemm_phase(LAS unsigned char* lds, const Gemm g, const Sched& S, const Epi& E) {
    const int tid = otid(g.wv), wid = __builtin_amdgcn_readfirstlane(tid >> 6), lane = tid & 63, wr = wid >> 2, wc = wid & 3, fr = lane & 15, fq = lane >> 4;
    const int K = g.ld, nt = g.nt, nth = g.nth;
    unsigned voffA[2], voffB[2];
#pragma unroll
    for (int i = 0; i < 2; ++i) { int R, C; stage_rc(tid * 16 + i * 8192, R, C); const int Rb = (R & ~31) + perm32(R & 31);
        voffA[i] = (unsigned)(R * K + C) * 2u; voffB[i] = (unsigned)(Rb * K + C) * 2u; }
    const size_t kstep = (size_t)(BK * 2);
    const size_t hstep = (size_t)HALF * K * 2;
    const size_t tstep = 2 * hstep;
    const unsigned ldsw = (unsigned)wid * 1024u;
    const int aoff = lds_byte(wr * 64 + fr, fq * 8), boff = lds_byte(wc * 32 + fr, fq * 8);
#define PG8_SA(b, h) (((b) * 2 + (h)) * HTB)
#define PG8_SB(b, h) ((4 + (b) * 2 + (h)) * HTB)
#define PG8_STAGE(bufoff, gbase, voff) do { _Pragma("unroll") for (int _i = 0; _i < 2; ++_i) \
        __builtin_amdgcn_global_load_lds((const unsigned*)((const char*)(gbase) + (voff)[_i]), (LAS unsigned*)(lds + (bufoff) + ldsw + _i * 8192), 16, 0, 0); } while (0)
#define PG8_LDA(dst, b, h) do { _Pragma("unroll") for (int m = 0; m < 4; ++m) _Pragma("unroll") for (int k = 0; k < 2; ++k) dst[m][k] = *(const LAS bf16x8*)(lds + PG8_SA(b, h) + aoff + m * 2048 + k * 1024); } while (0)
#define PG8_LDB(dst, b, h) do { _Pragma("unroll") for (int n = 0; n < 2; ++n) _Pragma("unroll") for (int k = 0; k < 2; ++k) dst[n][k] = *(const LAS bf16x8*)(lds + PG8_SB(b, h) + boff + n * 2048 + k * 1024); } while (0)
#define PG8_MMA(ai, bj, At, Bt) do { __builtin_amdgcn_s_setprio(1); _Pragma("unroll") for (int m = 0; m < 4; ++m) _Pragma("unroll") for (int n = 0; n < 2; ++n) _Pragma("unroll") for (int k = 0; k < 2; ++k) \
        acc[ai][bj][m][n] = __builtin_amdgcn_mfma_f32_16x16x32_bf16(Bt[n][k], At[m][k], acc[ai][bj][m][n], 0, 0, 0); __builtin_amdgcn_s_setprio(0); } while (0)
#define PG8_WAIT_V(n) asm volatile("s_waitcnt vmcnt(" #n ")" ::: "memory")
#define PG8_WAIT_L(n) asm volatile("s_waitcnt lgkmcnt(" #n ")" ::: "memory")
#define PG8_BAR __builtin_amdgcn_s_barrier()
#define PG8_SCHED __builtin_amdgcn_sched_barrier(0)
    Unit cur, nxt; int ui = 0;
    if (!S.next(0, cur)) return;
    f32x4 acc[2][2][4][2];
#pragma unroll
    for (int a = 0; a < 2; ++a)
#pragma unroll
        for (int b = 0; b < 2; ++b)
#pragma unroll
            for (int m = 0; m < 4; ++m)
#pragma unroll
                for (int n = 0; n < 2; ++n) acc[a][b][m][n] = (f32x4){0.f, 0.f, 0.f, 0.f};
    bf16x8 At[4][2], B0[2][2], B1[2][2];
    const char* cA = (const char*)g.A + (size_t)cur.pm * tstep; const char* cB = (const char*)g.Bt + (size_t)cur.pn * tstep;
    const long dA2 = (const char*)g.A2 - (const char*)g.A - (long)nth * (long)kstep, dB2 = (const char*)g.Bt2 - (const char*)g.Bt - (long)nth * (long)kstep;
    PG8_STAGE(PG8_SB(0, 0), cB, voffB); PG8_STAGE(PG8_SA(0, 0), cA, voffA); PG8_STAGE(PG8_SB(0, 1), cB + hstep, voffB); PG8_STAGE(PG8_SA(0, 1), cA + hstep, voffA);
    if (wr == 1) PG8_BAR;
    PG8_WAIT_V(4); PG8_BAR;
    PG8_STAGE(PG8_SB(1, 0), cB + kstep, voffB); PG8_STAGE(PG8_SA(1, 0), cA + kstep, voffA); PG8_STAGE(PG8_SB(1, 1), cB + hstep + kstep, voffB);
    PG8_WAIT_V(6); PG8_BAR;
    for (;;) {
        const bool has_next = S.next(ui + 1, nxt);
        const char* nA = has_next ? (const char*)g.A + (size_t)nxt.pm * tstep : cA; const char* nB = has_next ? (const char*)g.Bt + (size_t)nxt.pn * tstep : cB;
        for (int t = 0; t < nt; t += 2) {
            const bool last = (t == nt - 2);
            if constexpr (Epi::HAS_MID) { if (t == nth) { const int l2 = olane(); E.mid(acc, cur, wr, wc, l2 & 15, l2 >> 4); PG8_SCHED; } }
            const char* a1 = cA + (size_t)(t + 1) * kstep + (t + 1 >= nth ? dA2 : 0L);
            const char* a2 = last ? nA : cA + (size_t)(t + 2) * kstep + (t + 2 >= nth ? dA2 : 0L); const char* b2 = last ? nB : cB + (size_t)(t + 2) * kstep + (t + 2 >= nth ? dB2 : 0L);
            const char* a3 = a2 + kstep; const char* b3 = b2 + kstep;
            PG8_LDB(B0, 0, 0); PG8_SCHED; PG8_LDA(At, 0, 0); PG8_STAGE(PG8_SA(1, 1), a1 + hstep, voffA);
            PG8_WAIT_L(8); PG8_BAR; PG8_WAIT_L(0); PG8_MMA(0, 0, At, B0); PG8_BAR; PG8_SCHED;
            PG8_LDB(B1, 0, 1); PG8_STAGE(PG8_SB(0, 0), b2, voffB);
            PG8_BAR; PG8_WAIT_L(0); PG8_MMA(0, 1, At, B1); PG8_BAR;
            PG8_LDA(At, 0, 1); PG8_STAGE(PG8_SA(0, 0), a2, voffA);
            PG8_BAR; PG8_WAIT_L(0); PG8_MMA(1, 0, At, B0); PG8_BAR; PG8_SCHED;
            PG8_STAGE(PG8_SB(0, 1), b2 + hstep, voffB);
            PG8_WAIT_V(6); PG8_BAR; PG8_MMA(1, 1, At, B1); PG8_BAR;
            PG8_LDB(B0, 1, 0); PG8_SCHED; PG8_LDA(At, 1, 0); PG8_STAGE(PG8_SA(0, 1), a2 + hstep, voffA);
            PG8_WAIT_L(8); PG8_BAR; PG8_WAIT_L(0); PG8_MMA(0, 0, At, B0); PG8_BAR; PG8_SCHED;
            PG8_LDB(B1, 1, 1); PG8_STAGE(PG8_SB(1, 0), b3, voffB);
            PG8_BAR; PG8_WAIT_L(0); PG8_MMA(0, 1, At, B1); PG8_BAR;
            PG8_LDA(At, 1, 1); PG8_STAGE(PG8_SA(1, 0), a3, voffA);
            PG8_BAR; PG8_WAIT_L(0); PG8_MMA(1, 0, At, B0); PG8_BAR; PG8_SCHED;
            PG8_STAGE(PG8_SB(1, 1), b3 + hstep, voffB);
            PG8_WAIT_V(6); PG8_BAR; PG8_MMA(1, 1, At, B1); PG8_BAR;
        }
        if constexpr (!Epi::AFTER_DRAIN) { const int l2 = olane(); E(acc, cur, wr, wc, l2 & 15, l2 >> 4); }
        if (!has_next) break;
#pragma unroll
        for (int a = 0; a < 2; ++a)
#pragma unroll
            for (int b = 0; b < 2; ++b)
#pragma unroll
                for (int m = 0; m < 4; ++m)
#pragma unroll
                    for (int n = 0; n < 2; ++n) acc[a][b][m][n] = (f32x4){0.f, 0.f, 0.f, 0.f};
        cur = nxt; cA = nA; cB = nB; ++ui;
    }
    PG8_WAIT_V(0);
    if (wr == 0) PG8_BAR;
    PG8_BAR;
    if constexpr (Epi::AFTER_DRAIN) { const int l2 = olane(); E.fused(acc, cur, wr, wc, l2 & 15, l2 >> 4, lds); }
#undef PG8_SA
#undef PG8_SB
#undef PG8_STAGE
#undef PG8_LDA
#undef PG8_LDB
#undef PG8_MMA
#undef PG8_WAIT_V
#undef PG8_WAIT_L
#undef PG8_BAR
#undef PG8_SCHED
}
}
using pg8::Unit;
typedef f32x4 AccT[2][2][4][2];

DI void rowss_add(float* rss, int row, float s, int fq) {
    s += __shfl_xor(s, 16); s += __shfl_xor(s, 32);
    if (fq == 0) atomicAdd(rss + row, s);
}

struct EpiProj {
    static constexpr bool HAS_MID = false;
    static constexpr bool AFTER_DRAIN = false;
    bf16_t* proja; bf16_t* zg; float* small;
    DI void operator()(const AccT& acc, const Unit& u, int wr, int wc, int fr, int fq) const {
        const int row0 = u.pm * 256 + wr * 64 + fr, pn = u.pn;
        if (pn == 22) {
            if (wc == 0 && fq < 2) {
#pragma unroll
                for (int ai = 0; ai < 2; ++ai)
#pragma unroll
                    for (int m = 0; m < 4; ++m) { float* d = small + (size_t)(row0 + ai * 128 + m * 16) * 16 + 8 * fq;
                        *(f32x4*)d = acc[ai][0][m][0]; *(f32x4*)(d + 4) = acc[ai][0][m][1]; }
            }
            return;
        }
        bf16_t* base; int ld, colt, act;
        if (pn < 12) { base = proja; ld = 3072; colt = pn * 256; act = 0; }
        else if (pn < 14) { base = zg; ld = 2560; colt = (pn - 12) * 256; act = 1; }
        else { base = zg; ld = 2560; colt = 512 + (pn - 14) * 256; act = 2; }
#pragma unroll
        for (int ai = 0; ai < 2; ++ai)
#pragma unroll
            for (int m = 0; m < 4; ++m) { bf16_t* rowp = base + (size_t)(row0 + ai * 128 + m * 16) * ld + colt + wc * 32 + 8 * fq;
#pragma unroll
                for (int bj = 0; bj < 2; ++bj) { f32x4 v0 = acc[ai][bj][m][0], v1 = acc[ai][bj][m][1];
                    if (act) {
#pragma unroll
                        for (int j = 0; j < 4; ++j) { const float s0 = sigmoidf_(v0[j]), s1 = sigmoidf_(v1[j]); v0[j] = act == 1 ? v0[j] * s0 : s0; v1[j] = act == 1 ? v1[j] * s1 : s1; } }
                    u32x4 w = {pk2(v0[0], v0[1]), pk2(v0[2], v0[3]), pk2(v1[0], v1[1]), pk2(v1[2], v1[3])};
                    *(u32x4*)(rowp + bj * 128) = w; } }
    }
};
struct EpiMerge {
    static constexpr bool HAS_MID = true;
    static constexpr bool AFTER_DRAIN = false;
    const bf16_t* zg; bf16_t* merged;
    DI void mid(AccT& acc, const Unit& u, int wr, int wc, int fr, int fq) const {
        const int row0 = u.pm * 256 + wr * 64 + fr, col0 = u.pn * 256 + wc * 32 + 8 * fq;
#pragma unroll
        for (int ai = 0; ai < 2; ++ai)
#pragma unroll
            for (int m = 0; m < 4; ++m) { const size_t row = row0 + ai * 128 + m * 16;
                asm volatile("" ::: "memory");
#pragma unroll
                for (int bj = 0; bj < 2; ++bj) { const int col = col0 + bj * 128;
                    const u32x4 ga = *(const u32x4*)(zg + row * 2560 + 512 + col), gd = *(const u32x4*)(zg + row * 2560 + 1536 + col);
#pragma unroll
                    for (int e = 0; e < 4; ++e) { const float r0 = bf_lo(ga[e]) * __builtin_amdgcn_rcpf(fmaxf(bf_lo(gd[e]), 1e-30f)), r1 = bf_hi(ga[e]) * __builtin_amdgcn_rcpf(fmaxf(bf_hi(gd[e]), 1e-30f));
                        acc[ai][bj][m][e >> 1][(e & 1) * 2] *= r0; acc[ai][bj][m][e >> 1][(e & 1) * 2 + 1] *= r1; } } }
    }
    DI void operator()(const AccT& acc, const Unit& u, int wr, int wc, int fr, int fq) const {
        const int row0 = u.pm * 256 + wr * 64 + fr, col0 = u.pn * 256 + wc * 32 + 8 * fq;
#pragma unroll
        for (int ai = 0; ai < 2; ++ai)
#pragma unroll
            for (int m = 0; m < 4; ++m) { const size_t row = row0 + ai * 128 + m * 16;
#pragma unroll
                for (int bj = 0; bj < 2; ++bj) { const int col = col0 + bj * 128;
                    const u32x4 gw = *(const u32x4*)(zg + row * 2560 + 1536 + col);
                    const f32x4 g0 = {fmaxf(bf_lo(gw[0]), 1e-30f), fmaxf(bf_hi(gw[0]), 1e-30f), fmaxf(bf_lo(gw[1]), 1e-30f), fmaxf(bf_hi(gw[1]), 1e-30f)}, g1 = {fmaxf(bf_lo(gw[2]), 1e-30f), fmaxf(bf_hi(gw[2]), 1e-30f), fmaxf(bf_lo(gw[3]), 1e-30f), fmaxf(bf_hi(gw[3]), 1e-30f)};
                    const f32x4 v0 = acc[ai][bj][m][0] * g0, v1 = acc[ai][bj][m][1] * g1;
                    u32x4 w = {pk2(v0[0], v0[1]), pk2(v0[2], v0[3]), pk2(v1[0], v1[1]), pk2(v1[2], v1[3])};
                    *(u32x4*)(merged + row * 1024 + col) = w; } }
    }
};
template <bool BASE_BF16>
struct EpiResid {
    static constexpr bool HAS_MID = false;
    static constexpr bool AFTER_DRAIN = false;
    const void* base; bf16_t* hb; float* rss;
    DI void operator()(const AccT& acc, const Unit& u, int wr, int wc, int fr, int fq) const {
        const int row0 = u.pm * 256 + wr * 64 + fr, col0 = u.pn * 256 + wc * 32 + 8 * fq;
#pragma unroll
        for (int ai = 0; ai < 2; ++ai)
#pragma unroll
            for (int m = 0; m < 4; ++m) { const size_t row = row0 + ai * 128 + m * 16; float ss = 0.f;
#pragma unroll
                for (int bj = 0; bj < 2; ++bj) { const size_t o = row * 1024 + col0 + bj * 128;
                    f32x4 b0, b1;
                    if (BASE_BF16) { const u32x4 bw = *(const u32x4*)((const bf16_t*)base + o); b0 = (f32x4){bf_lo(bw[0]), bf_hi(bw[0]), bf_lo(bw[1]), bf_hi(bw[1])}; b1 = (f32x4){bf_lo(bw[2]), bf_hi(bw[2]), bf_lo(bw[3]), bf_hi(bw[3])}; }
                    else { b0 = *(const f32x4*)((const float*)base + o); b1 = *(const f32x4*)((const float*)base + o + 4); }
                    const f32x4 v0 = b0 + acc[ai][bj][m][0], v1 = b1 + acc[ai][bj][m][1];
                    u32x4 w = {pk2(v0[0], v0[1]), pk2(v0[2], v0[3]), pk2(v1[0], v1[1]), pk2(v1[2], v1[3])};
                    *(u32x4*)(hb + o) = w;
#pragma unroll
                    for (int j = 0; j < 4; ++j) ss += v0[j] * v0[j] + v1[j] * v1[j]; }
                rowss_add(rss, (int)row, ss, fq); }
    }
};
template <bool BASE_BF16>
struct EpiResidDrain {
    static constexpr bool HAS_MID = false;
    static constexpr bool AFTER_DRAIN = true;
    const void* base; bf16_t* hb; float* rss;
    DI void operator()(const AccT&, const Unit&, int, int, int, int) const {}
    DI void fused(AccT& acc, const Unit& u, int wr, int wc, int fr, int fq, LAS unsigned char* lds) const {
        const int row0 = u.pm * 256 + wr * 64 + fr, col0 = u.pn * 256 + wc * 32 + 8 * fq;
        LAS float* PS = (LAS float*)lds;
#pragma unroll
        for (int ai = 0; ai < 2; ++ai)
#pragma unroll
            for (int m = 0; m < 4; ++m) { const size_t row = row0 + ai * 128 + m * 16; float ss = 0.f;
#pragma unroll
                for (int bj = 0; bj < 2; ++bj) { const size_t o = row * 1024 + col0 + bj * 128;
                    f32x4 b0, b1;
                    if (BASE_BF16) { const u32x4 bw = *(const u32x4*)((const bf16_t*)base + o); b0 = (f32x4){bf_lo(bw[0]), bf_hi(bw[0]), bf_lo(bw[1]), bf_hi(bw[1])}; b1 = (f32x4){bf_lo(bw[2]), bf_hi(bw[2]), bf_lo(bw[3]), bf_hi(bw[3])}; }
                    else { b0 = *(const f32x4*)((const float*)base + o); b1 = *(const f32x4*)((const float*)base + o + 4); }
                    const f32x4 v0 = b0 + acc[ai][bj][m][0], v1 = b1 + acc[ai][bj][m][1];
                    u32x4 w = {pk2(v0[0], v0[1]), pk2(v0[2], v0[3]), pk2(v1[0], v1[1]), pk2(v1[2], v1[3])};
                    *(u32x4*)(hb + o) = w;
#pragma unroll
                    for (int j = 0; j < 4; ++j) ss += v0[j] * v0[j] + v1[j] * v1[j]; }
                ss += __shfl_xor(ss, 16); ss += __shfl_xor(ss, 32);
                if (fq == 0) PS[(ai * 128 + wr * 64 + m * 16 + fr) * 4 + wc] = ss; }
        __syncthreads();
        const int t_ = (wr * 4 + wc) * 64 + fq * 16 + fr;
        if (t_ < 256) { const f32x4 p4 = *(const LAS f32x4*)(PS + t_ * 4); atomicAdd(rss + u.pm * 256 + t_, (p4[0] + p4[1]) + (p4[2] + p4[3])); }
    }
};
struct EpiFF1 {
    static constexpr bool HAS_MID = false;
    static constexpr bool AFTER_DRAIN = false;
    const float* rss; bf16_t* act; const LAS float* tab; int pm0;
    DI void operator()(const AccT& acc, const Unit& u, int wr, int wc, int fr, int fq) const {
        const int row0 = u.pm * 256 + wr * 64 + fr, col0 = u.pn * 256 + wc * 32 + 8 * fq;
#pragma unroll
        for (int ai = 0; ai < 2; ++ai)
#pragma unroll
            for (int m = 0; m < 4; ++m) { const size_t row = row0 + ai * 128 + m * 16; const float rstd = (u.pm == pm0) ? tab[ai * 128 + wr * 64 + m * 16 + fr] : rsqrtf(rss[row] * (1.0f / 1024.0f) + EPS);
#pragma unroll
                for (int bj = 0; bj < 2; ++bj) { f32x4 v0 = acc[ai][bj][m][0] * rstd, v1 = acc[ai][bj][m][1] * rstd;
#pragma unroll
                    for (int j = 0; j < 4; ++j) { const float a0 = fmaxf(v0[j], 0.f), a1 = fmaxf(v1[j], 0.f); v0[j] = a0 * a0; v1[j] = a1 * a1; }
                    u32x4 w = {pk2(v0[0], v0[1]), pk2(v0[2], v0[3]), pk2(v1[0], v1[1]), pk2(v1[2], v1[3])};
                    *(u32x4*)(act + row * 4096 + col0 + bj * 128) = w; } }
    }
};
struct EpiPP {
    static constexpr bool HAS_MID = false;
    static constexpr bool AFTER_DRAIN = false;
    bf16_t* pp;
    DI void operator()(const AccT& acc, const Unit& u, int wr, int wc, int fr, int fq) const {
        const int row0 = u.pm * 256 + wr * 64 + fr, col0 = u.pn * 256 + wc * 32 + 8 * fq;
#pragma unroll
        for (int ai = 0; ai < 2; ++ai)
#pragma unroll
            for (int m = 0; m < 4; ++m) { const size_t row = row0 + ai * 128 + m * 16;
#pragma unroll
                for (int bj = 0; bj < 2; ++bj) { const f32x4 v0 = acc[ai][bj][m][0], v1 = acc[ai][bj][m][1];
                    u32x4 w = {pk2(v0[0], v0[1]), pk2(v0[2], v0[3]), pk2(v1[0], v1[1]), pk2(v1[2], v1[3])};
                    *(u32x4*)(pp + row * 1024 + col0 + bj * 128) = w; } }
    }
};
struct EpiGate {
    static constexpr bool HAS_MID = false;
    static constexpr bool AFTER_DRAIN = false;
    const float* rss2; const bf16_t* pp; const bf16_t* hin; float* h; float* rss3;
    DI void operator()(const AccT& acc, const Unit& u, int wr, int wc, int fr, int fq) const {
        const int row0 = u.pm * 256 + wr * 64 + fr, col0 = u.pn * 256 + wc * 32 + 8 * fq;
#pragma unroll
        for (int ai = 0; ai < 2; ++ai)
#pragma unroll
            for (int m = 0; m < 4; ++m) { const size_t row = row0 + ai * 128 + m * 16; const float rstd = rsqrtf(rss2[row] * (1.0f / 1024.0f) + EPS); float ss = 0.f;
#pragma unroll
                for (int bj = 0; bj < 2; ++bj) { const size_t o = row * 1024 + col0 + bj * 128;
                    const u32x4 pw = *(const u32x4*)(pp + o);
                    const f32x4 p0 = {bf_lo(pw[0]), bf_hi(pw[0]), bf_lo(pw[1]), bf_hi(pw[1])}, p1 = {bf_lo(pw[2]), bf_hi(pw[2]), bf_lo(pw[3]), bf_hi(pw[3])};
                    const u32x4 hw = *(const u32x4*)(hin + o);
                    f32x4 v0 = {bf_lo(hw[0]), bf_hi(hw[0]), bf_lo(hw[1]), bf_hi(hw[1])}, v1 = {bf_lo(hw[2]), bf_hi(hw[2]), bf_lo(hw[3]), bf_hi(hw[3])};
#pragma unroll
                    for (int j = 0; j < 4; ++j) { v0[j] += sigmoidf_(acc[ai][bj][m][0][j] * rstd) * p0[j]; v1[j] += sigmoidf_(acc[ai][bj][m][1][j] * rstd) * p1[j]; ss += v0[j] * v0[j] + v1[j] * v1[j]; }
                    *(f32x4*)(h + o) = v0; *(f32x4*)(h + o + 4) = v1; }
                rowss_add(rss3, (int)row, ss, fq); }
    }
};

struct EpiGateFinal {
    static constexpr bool HAS_MID = false;
    static constexpr bool AFTER_DRAIN = true;
    const float* rss2; const bf16_t* pp; const bf16_t* h; float* out; float* rss3; unsigned* cnt; const float* gfin; int wv;
    DI void operator()(const AccT&, const Unit&, int, int, int, int) const {}
    DI void fused(AccT& acc, const Unit& u, int wr, int wc, int fr, int fq, LAS unsigned char* lds) const {
        const int row0 = u.pm * 256 + wr * 64 + fr, col0 = u.pn * 256 + wc * 32 + 8 * fq;
        LAS float* PS = (LAS float*)lds;
#pragma unroll
        for (int ai = 0; ai < 2; ++ai)
#pragma unroll
            for (int m = 0; m < 4; ++m) { const size_t row = row0 + ai * 128 + m * 16; const float rstd = rsqrtf(rss2[row] * (1.0f / 1024.0f) + EPS); float ss = 0.f;
#pragma unroll
                for (int bj = 0; bj < 2; ++bj) { const size_t o = row * 1024 + col0 + bj * 128;
                    const u32x4 pw = *(const u32x4*)(pp + o);
                    const f32x4 p0 = {bf_lo(pw[0]), bf_hi(pw[0]), bf_lo(pw[1]), bf_hi(pw[1])}, p1 = {bf_lo(pw[2]), bf_hi(pw[2]), bf_lo(pw[3]), bf_hi(pw[3])};
                    const u32x4 hw = *(const u32x4*)(h + o);
                    f32x4 v0 = {bf_lo(hw[0]), bf_hi(hw[0]), bf_lo(hw[1]), bf_hi(hw[1])}, v1 = {bf_lo(hw[2]), bf_hi(hw[2]), bf_lo(hw[3]), bf_hi(hw[3])};
#pragma unroll
                    for (int j = 0; j < 4; ++j) { v0[j] += sigmoidf_(acc[ai][bj][m][0][j] * rstd) * p0[j]; v1[j] += sigmoidf_(acc[ai][bj][m][1][j] * rstd) * p1[j]; ss += v0[j] * v0[j] + v1[j] * v1[j]; }
                    acc[ai][bj][m][0] = v0; acc[ai][bj][m][1] = v1; }
                ss += __shfl_xor(ss, 16); ss += __shfl_xor(ss, 32);
                if (fq == 0) PS[(ai * 128 + wr * 64 + m * 16 + fr) * 4 + wc] = ss; }
        __syncthreads();
        { const int t_ = (wr * 4 + wc) * 64 + fq * 16 + fr;
          if (t_ < 256) { const f32x4 p4 = *(const LAS f32x4*)(PS + t_ * 4); atomicAdd(rss3 + u.pm * 256 + t_, (p4[0] + p4[1]) + (p4[2] + p4[3])); } }
        asm volatile("s_waitcnt vmcnt(0)" ::: "memory");
        __syncthreads();
        if (wv == 0 && olane() == 0) {
            __hip_atomic_fetch_add(cnt + 16 * u.pm, 1u, __ATOMIC_RELEASE, __HIP_MEMORY_SCOPE_AGENT);
            unsigned sp = 0;
            while (__hip_atomic_load(cnt + 16 * u.pm, __ATOMIC_RELAXED, __HIP_MEMORY_SCOPE_AGENT) < 4u) { __builtin_amdgcn_s_sleep(1); if (++sp > (1u << 22)) break; }
            __builtin_amdgcn_fence(__ATOMIC_ACQUIRE, "agent");
            asm volatile("s_waitcnt vmcnt(0)" ::: "memory");
        }
        __syncthreads();
#pragma unroll
        for (int ai = 0; ai < 2; ++ai)
#pragma unroll
            for (int m = 0; m < 4; ++m) { const size_t row = row0 + ai * 128 + m * 16;
                const float rstd3 = rsqrtf(__hip_atomic_load(rss3 + row, __ATOMIC_RELAXED, __HIP_MEMORY_SCOPE_AGENT) * (1.0f / 1024.0f) + EPS);
#pragma unroll
                for (int bj = 0; bj < 2; ++bj) { const size_t o = row * 1024 + col0 + bj * 128; const int col = col0 + bj * 128;
                    const f32x4 g0 = *(const f32x4*)(gfin + col), g1 = *(const f32x4*)(gfin + col + 4);
                    *(f32x4*)(out + o) = acc[ai][bj][m][0] * rstd3 * g0; *(f32x4*)(out + o + 4) = acc[ai][bj][m][1] * rstd3 * g1; } }
    }
};

DI int win_colmap(int j) { return j < 3584 ? j : (j < 5632 ? j + 16 : (j < 5648 ? j - 2048 : -1)); }
template <int MODE>
DI void tr_item(const float* W, int ldw, int K, bf16_t* WT, int row_off, const float* gain, LAS float* scr, int item, int nblk, int lane) {
    const int kb = item / nblk, nb = item % nblk, k0 = 64 * kb, n0 = 32 * nb;
    const int j = n0 + (lane & 31);
    const int src = MODE == 1 ? win_colmap(j) : j;
    float tv[32];
#pragma unroll
    for (int i = 0; i < 32; ++i) { const int kk = 2 * i + (lane >> 5); tv[i] = W[(size_t)(k0 + kk) * ldw + (src >= 0 ? src : 0)]; }
    if (gain) {
#pragma unroll
        for (int i = 0; i < 32; ++i) tv[i] *= gain[k0 + 2 * i + (lane >> 5)]; }
#pragma unroll
    for (int i = 0; i < 32; ++i) { const int kk = 2 * i + (lane >> 5); scr[kk * 33 + (lane & 31)] = src >= 0 ? tv[i] : 0.f; }
    LDS_WAIT();
    const int c = lane & 7;
#pragma unroll
    for (int jj = 0; jj < 4; ++jj) { const int n = (lane >> 3) + 8 * jj; const LAS float* s = scr + (8 * c) * 33 + n;
        u32x4 o = {pk2(s[0], s[33]), pk2(s[66], s[99]), pk2(s[132], s[165]), pk2(s[198], s[231])};
        *(u32x4*)(WT + (size_t)(row_off + n0 + n) * K + k0 + 8 * c) = o; }
    LDS_WAIT();
}
DI void p0_weights(const Args& a, LAS unsigned char* lds, int it0, int it1, int vc, int nvc) {
    const int tid = otid(a.wv), lane = tid & 63, w = tid >> 6;
    unsigned char* ws = a.ws;
    LAS float* scr = (LAS float*)(lds + w * 8704);
    constexpr int I_IN = 16 * 184, I_A = 8 * 32, I_O = 16 * 32, I_1 = 16 * 128, I_2 = 64 * 32;
    for (int it = it0 + vc * 8 + w; it < it1; it += nvc * 8) {
        int r = it;
        if (r < I_IN) { tr_item<1>(a.in[3], 5648, 1024, (bf16_t*)(ws + OFF_WIN), 0, nullptr, scr, r, 184, lane); continue; } r -= I_IN;
        if (r < I_A) { tr_item<0>(a.in[11], 1024, 512, (bf16_t*)(ws + OFF_WAD), 0, nullptr, scr, r, 32, lane); continue; } r -= I_A;
        if (r < I_A) { tr_item<0>(a.in[12], 1024, 512, (bf16_t*)(ws + OFF_WAD), 1024, nullptr, scr, r, 32, lane); continue; } r -= I_A;
        if (r < I_O) { tr_item<0>(a.in[13], 1024, 1024, (bf16_t*)(ws + OFF_WO), 0, nullptr, scr, r, 32, lane); continue; } r -= I_O;
        if (r < I_1) { tr_item<0>(a.in[15], 4096, 1024, (bf16_t*)(ws + OFF_W1), 0, a.in[14], scr, r, 128, lane); continue; } r -= I_1;
        if (r < I_2) { tr_item<0>(a.in[16], 1024, 4096, (bf16_t*)(ws + OFF_W2), 0, nullptr, scr, r, 32, lane); continue; } r -= I_2;
        if (r < I_O) { tr_item<0>(a.in[18], 1024, 1024, (bf16_t*)(ws + OFF_WPG), 0, a.in[17], scr, r, 32, lane); continue; } r -= I_O;
        tr_item<0>(a.in[19], 1024, 256, (bf16_t*)(ws + OFF_WPP), 0, nullptr, scr, r, 32, lane);
    }
}
constexpr int P0_I_IN = 16 * 184, P0_NIT = 16 * 184 + 2 * 8 * 32 + 16 * 32 + 16 * 128 + 64 * 32 + 16 * 32 + 4 * 32;
DI void phase0(const Args& a, LAS unsigned char* lds) {
    const int tid = otid(a.wv), lane = tid & 63, w = tid >> 6;
    const int gw = blockIdx.x * 8 + w, NGW = gridDim.x * 8;
    unsigned char* ws = a.ws;
    p0_weights(a, lds, 0, gridDim.x == 256 ? P0_I_IN : P0_NIT, blockIdx.x, gridDim.x);
    const float* x = a.in[0]; const float* gm = a.in[2]; bf16_t* xn = (bf16_t*)(ws + A_XN);
    for (int row0 = gw * 2; row0 < MTOK; row0 += NGW * 2) {
        f32x4 v[2][4]; float s[2] = {0.f, 0.f};
#pragma unroll
        for (int r = 0; r < 2; ++r) { const f32x4* xr = (const f32x4*)(x + (size_t)(row0 + r) * 1024) + lane;
#pragma unroll
            for (int j = 0; j < 4; ++j) v[r][j] = xr[64 * j]; }
#pragma unroll
        for (int r = 0; r < 2; ++r)
#pragma unroll
            for (int j = 0; j < 4; ++j) s[r] += (v[r][j][0] * v[r][j][0] + v[r][j][1] * v[r][j][1]) + (v[r][j][2] * v[r][j][2] + v[r][j][3] * v[r][j][3]);
#pragma unroll
        for (int o = 1; o < 64; o <<= 1) { s[0] += __shfl_xor(s[0], o); s[1] += __shfl_xor(s[1], o); }
#pragma unroll
        for (int r = 0; r < 2; ++r) { const float rstd = rsqrtf(s[r] * (1.0f / 1024.0f) + EPS);
            u32x2* o8 = (u32x2*)(xn + (size_t)(row0 + r) * 1024) + lane;
#pragma unroll
            for (int j = 0; j < 4; ++j) { const f32x4 g = *((const f32x4*)gm + lane + 64 * j);
                u32x2 o = {pk2(v[r][j][0] * rstd * g[0], v[r][j][1] * rstd * g[1]), pk2(v[r][j][2] * rstd * g[2], v[r][j][3] * rstd * g[3])}; o8[64 * j] = o; } }
    }
    { float* rss = (float*)(ws + OFF_RSS); for (int i = blockIdx.x * 512 + tid; i < 3 * MTOK; i += gridDim.x * 512) rss[i] = 0.f;
      unsigned* cnt = (unsigned*)(ws + OFF_CNT); for (int i = blockIdx.x * 512 + tid; i < 1024; i += gridDim.x * 512) cnt[i] = 0u;
      unsigned* flg = (unsigned*)(ws + OFF_FLG); for (int i = blockIdx.x * 512 + tid; i < 4096; i += gridDim.x * 512) flg[i] = 0u; }
}

DI float softplusf_(float x) { return fmaxf(x, 0.f) + log1pf(__expf(-fabsf(x))); }
DI float siluf_(float v) { return v * sigmoidf_(v); }
template <int KIND>
DI void p2_head(const Args& a, int b, int s0, int h, int lane) {
    const bf16_t* proja = (const bf16_t*)(a.ws + A_PROJA);
    bf16_t* QT = (bf16_t*)a.out; bf16_t* KT = QT + (size_t)MTOK * 512; bf16_t* VT = KT + (size_t)MTOK * 512; bf16_t* KTT = (bf16_t*)(a.ws + A_KTT);
    const int ch = KIND * 512 + h * 128 + 2 * lane;
    const float* cw = a.in[5];
    const float w00 = cw[ch], w01 = cw[ch + 1], w10 = cw[1536 + ch], w11 = cw[1536 + ch + 1], w20 = cw[3072 + ch], w21 = cw[3072 + ch + 1];
    const unsigned* src = (const unsigned*)(proja + (size_t)b * SEQ * 3072 + 1536 + ch);
    unsigned rw[34];
#pragma unroll
    for (int t = 0; t < 34; ++t) { const int s = s0 - 1 + t; rw[t] = (s >= 0 && s < SEQ) ? src[(size_t)s * 1536] : 0u; }
    float lo[32], hi[32], ss[32];
#pragma unroll
    for (int t = 0; t < 32; ++t) {
        lo[t] = siluf_(bf_lo(rw[t]) * w00 + bf_lo(rw[t + 1]) * w10 + bf_lo(rw[t + 2]) * w20);
        hi[t] = siluf_(bf_hi(rw[t]) * w01 + bf_hi(rw[t + 1]) * w11 + bf_hi(rw[t + 2]) * w21);
        ss[t] = lo[t] * lo[t] + hi[t] * hi[t];
    }
    if (KIND < 2) {
#pragma unroll
        for (int o = 1; o < 64; o <<= 1)
#pragma unroll
            for (int t = 0; t < 32; ++t) ss[t] += __shfl_xor(ss[t], o);
#pragma unroll
        for (int t = 0; t < 32; ++t) { const float rn = rsqrtf(ss[t] + EPS) * (KIND == 0 ? 0.08838834764831845f : 1.0f); lo[t] *= rn; hi[t] *= rn; }
    }
#pragma unroll
    for (int t = 0; t < 32; ++t) {
        const size_t tok = (size_t)b * SEQ + s0 + t;
        if (KIND == 2) { *(unsigned*)(VT + tok * 512 + h * 128 + 2 * lane) = pk2(lo[t], hi[t]); }
        else { const int d = 2 * lane, d32 = d & 31, pos = (d & ~31) + ((d32 >> 2) & 3) * 8 + (d32 >> 4) * 4 + (d32 & 3);
            *(unsigned*)((KIND == 0 ? QT : KT) + tok * 512 + h * 128 + pos) = pk2(lo[t], hi[t]); }
    }
    if (KIND == 1) {
        bf16_t* r0 = KTT + ((size_t)((b * 4 + h) * 128 + 2 * lane) * SEQ + s0);
        bf16_t* r1 = r0 + SEQ;
#pragma unroll
        for (int q4 = 0; q4 < 4; ++q4) { u32x4 o0, o1;
#pragma unroll
            for (int e = 0; e < 4; ++e) { const int p = q4 * 8 + e * 2, t0 = ((p & 7) >> 2) * 16 + (p >> 3) * 4 + (p & 3), t1 = t0 + 1;
                o0[e] = pk2(lo[t0], lo[t1]); o1[e] = pk2(hi[t0], hi[t1]); }
            *(u32x4*)(r0 + q4 * 8) = o0; *(u32x4*)(r1 + q4 * 8) = o1; }
    }
}
DI void p2_mixa(const Args& a, int b, int s0, int blk, int lane) {
    const bf16_t* proja = (const bf16_t*)(a.ws + A_PROJA);
    bf16_t* YA = (bf16_t*)a.out + (size_t)3 * MTOK * 512;
    const int c = blk * 128 + 2 * lane;
    const float* cw = a.in[4];
    const float w00 = cw[c], w01 = cw[c + 1], w10 = cw[512 + c], w11 = cw[512 + c + 1], w20 = cw[1024 + c], w21 = cw[1024 + c + 1];
    const unsigned* src = (const unsigned*)(proja + (size_t)b * SEQ * 3072 + c);
    float p0 = 0.f, p1 = 0.f, c0, c1;
    if (s0 > 0) { const unsigned bb = src[(size_t)(s0 - 1) * 1536], xx = src[(size_t)(s0 - 1) * 1536 + 512]; p0 = bf_lo(bb) * bf_lo(xx); p1 = bf_hi(bb) * bf_hi(xx); }
    { const unsigned bb = src[(size_t)s0 * 1536], xx = src[(size_t)s0 * 1536 + 512]; c0 = bf_lo(bb) * bf_lo(xx); c1 = bf_hi(bb) * bf_hi(xx); }
#pragma unroll 4
    for (int t = 0; t < 32; ++t) {
        const int s = s0 + t; float n0 = 0.f, n1 = 0.f;
        if (s + 1 < SEQ) { const unsigned bb = src[(size_t)(s + 1) * 1536], xx = src[(size_t)(s + 1) * 1536 + 512]; n0 = bf_lo(bb) * bf_lo(xx); n1 = bf_hi(bb) * bf_hi(xx); }
        const unsigned cc = src[(size_t)s * 1536 + 256];
        const float y0 = bf_lo(cc) * (p0 * w00 + c0 * w10 + n0 * w20), y1 = bf_hi(cc) * (p1 * w01 + c1 * w11 + n1 * w21);
        *(unsigned*)(YA + ((size_t)b * SEQ + s) * 512 + c) = pk2(y0, y1);
        p0 = c0; p1 = c1; c0 = n0; c1 = n1;
    }
}
DI void phase2(const Args& a) {
    const int tid = otid(a.wv), lane = tid & 63, w = tid >> 6;
    { const float* sm = (const float*)(a.ws + OFF_SMALL); float* gb = (float*)(a.ws + OFF_GB);
      for (int i = blockIdx.x * 512 + tid; i < MTOK * 4; i += gridDim.x * 512) { const int t = i >> 2, h = i & 3; const float* r = sm + (size_t)t * 16;
          gb[t * 16 + h] = -__expf(a.in[6][h]) * softplusf_(r[8 + h] + a.in[8][h]);
          gb[t * 16 + 4 + h] = -__expf(a.in[7][h]) * softplusf_(r[12 + h] + a.in[9][h]);
          gb[t * 16 + 8 + h] = sigmoidf_(r[h]); gb[t * 16 + 12 + h] = sigmoidf_(r[4 + h]); } }
    const int gw = blockIdx.x * 8 + w, NGW = gridDim.x * 8;
    for (int it = gw; it < 512 * 16; it += NGW) {
        const int grp = it >> 4, sec = it & 15, b = grp >> 8, s0 = (grp & 255) * 32;
        if (sec < 4) p2_head<0>(a, b, s0, sec, lane);
        else if (sec < 8) p2_head<1>(a, b, s0, sec - 4, lane);
        else if (sec < 12) p2_head<2>(a, b, s0, sec - 8, lane);
        else p2_mixa(a, b, s0, sec - 12, lane);
    }
}

constexpr int L_QS = 0, L_KS = 17408, L_KTS = 34816, L_VTS = 53248, L_AM = 71680, L_TW = 104448, L_TU = 122880, L_GS = 141312;
typedef short s16x4 __attribute__((ext_vector_type(4)));
DI unsigned p3_offb(unsigned row, unsigned ch) { return 256u * row + 16u * (ch ^ (((row & 3u) << 2) | ((row >> 2) & 3u))); }
DI bf16x8 p3_tr_frag(LAS unsigned char* img, int lane, int c, int ks) {
    const unsigned g = (unsigned)lane >> 4, q = ((unsigned)lane & 15u) >> 2, p = (unsigned)lane & 3u;
    const s16x4 r0 = __builtin_amdgcn_ds_read_tr16_b64_v4i16((LAS s16x4*)(img + p3_offb(32u * ks + 8u * g + q, 2u * c + (p >> 1)) + 8u * (p & 1u)));
    const s16x4 r1 = __builtin_amdgcn_ds_read_tr16_b64_v4i16((LAS s16x4*)(img + p3_offb(32u * ks + 8u * g + 4u + q, 2u * c + (p >> 1)) + 8u * (p & 1u)));
    return __builtin_shufflevector(r0, r1, 0, 1, 2, 3, 4, 5, 6, 7);
}
DI void phase3(const Args& a, LAS unsigned char* lds) {
    const bf16_t* QT = (const bf16_t*)a.out; const bf16_t* KT = QT + (size_t)MTOK * 512; const bf16_t* VT = KT + (size_t)MTOK * 512;
    const float* GB = (const float*)(a.ws + OFF_GB);
    unsigned char* OPS = a.ws + A_OPS;
    for (int task = blockIdx.x; task < 1024; task += gridDim.x) {
        const int tid = otid(a.wv), lane = tid & 63, w = tid >> 6, dir = w >> 2, wq = w & 3, m16 = lane & 15, kg = lane >> 4;
        const int bh = task >> 7, nc = task & 127, b = bh >> 2, h = bh & 3;
        const size_t tb = (size_t)b * SEQ + nc * 64;
#pragma unroll
        for (int e = 0; e < 2; ++e) {
            const int ch = tid + 512 * e, row = ch >> 4, c16 = ch & 15;
            const size_t g = (tb + row) * 512 + h * 128 + c16 * 8;
            const u32x4 q = *(const u32x4*)(QT + g); *(LAS u32x4*)(lds + L_QS + row * 272 + c16 * 16) = q;
            const u32x4 k = *(const u32x4*)(KT + g); *(LAS u32x4*)(lds + L_KS + row * 272 + c16 * 16) = k;
            const u32x4 v = *(const u32x4*)(VT + g);
            const int grp = c16 >> 2, kgs = c16 & 3;
            *(LAS u32x4*)(lds + L_VTS + p3_offb(row, c16)) = v;
            { u32x2 k0 = {k[0], k[1]}, k1 = {k[2], k[3]};
              *(LAS u32x2*)(lds + L_KTS + p3_offb(row, grp * 4 + (kgs >> 1)) + 8 * (kgs & 1)) = k0;
              *(LAS u32x2*)(lds + L_KTS + p3_offb(row, grp * 4 + 2 + (kgs >> 1)) + 8 * (kgs & 1)) = k1; }
        }
        if (w < 2) {
            const size_t tok = tb + (w ? 63 - lane : lane);
            float g = GB[tok * 16 + w * 4 + h]; const float bt = GB[tok * 16 + 8 + w * 4 + h];
#pragma unroll
            for (int o = 1; o < 64; o <<= 1) { const float t = __shfl_up(g, o); if (lane >= o) g += t; }
            LAS float* gs = (LAS float*)(lds + L_GS + w * 512);
            gs[lane] = g; gs[64 + lane] = bt;
        }
        __syncthreads();
        const LAS float* Gc = (const LAS float*)(lds + L_GS + dir * 512); const LAS float* Bt = Gc + 64;
        unsigned char* ops = OPS + (size_t)(task * 2 + dir) * OPS_TASK;
        {
            const int prow = dir ? 63 - (wq * 16 + m16) : wq * 16 + m16;
            bf16x8 Af[4], Qf[4];
#pragma unroll
            for (int kk = 0; kk < 4; ++kk) { Af[kk] = *(const LAS bf16x8*)(lds + L_KS + prow * 272 + (kk * 32 + kg * 8) * 2); Qf[kk] = *(const LAS bf16x8*)(lds + L_QS + prow * 272 + (kk * 32 + kg * 8) * 2); }
            LAS float* AM = (LAS float*)(lds + L_AM + dir * 16384);
            f32x4 tl[4];
#pragma unroll
            for (int t = 0; t < 4; ++t) {
                tl[t] = (f32x4){0.f, 0.f, 0.f, 0.f};
                if (t <= wq) {
                    const int trow = dir ? 63 - (t * 16 + m16) : t * 16 + m16;
                    bf16x8 Kf[4];
#pragma unroll
                    for (int kk = 0; kk < 4; ++kk) Kf[kk] = *(const LAS bf16x8*)(lds + L_KS + trow * 272 + (kk * 32 + kg * 8) * 2);
                    f32x4 akk = {0.f, 0.f, 0.f, 0.f}, akq = {0.f, 0.f, 0.f, 0.f};
#pragma unroll
                    for (int kk = 0; kk < 4; ++kk) { akk = MFMA16(Af[kk], Kf[kk], akk); akq = MFMA16(Kf[kk], Qf[kk], akq); }
                    const int jc = t * 16 + m16; const float gj = Gc[jc];
                    const int cq = wq * 16 + m16; const float gcq = Gc[cq];
#pragma unroll
                    for (int r = 0; r < 4; ++r) {
                        const int c = wq * 16 + kg * 4 + r;
                        AM[c * 64 + jc] = (c > jc) ? Bt[c] * akk[r] * __expf(fminf(Gc[c] - gj, 0.f)) : 0.f;
                        const int jj = t * 16 + kg * 4 + r;
                        tl[t][r] = (cq >= jj) ? akq[r] * __expf(fminf(gcq - Gc[jj], 0.f)) : 0.f;
                    }
                }
            }
#pragma unroll
            for (int kk = 0; kk < 2; ++kk) *(bf16x8*)(ops + 16384 + (wq * 2 + kk) * 1024 + lane * 16) = pack8(tl[2 * kk], tl[2 * kk + 1]);
        }
        __syncthreads();
        if (wq == 0) {
            const LAS float* AM = (const LAS float*)(lds + L_AM + dir * 16384);
            typedef float f32x64 __attribute__((ext_vector_type(64))); f32x64 x;
            int lane_o = lane; asm volatile("" : "+v"(lane_o));
            f32x4 av[16], an[8];
#pragma unroll
            for (int q = 0; q < 16; ++q) av[q] = (f32x4){0.f, 0.f, 0.f, 0.f};
#pragma unroll
            for (int q = 0; q < 8; ++q) an[q] = (f32x4){0.f, 0.f, 0.f, 0.f};
            av[0] = *(const LAS f32x4*)(AM + 64);
            x[0] = (lane_o == 0) ? 1.f : 0.f;
#pragma unroll
            for (int i = 1; i < 64; ++i) {
#pragma unroll
                for (int j4 = 8; j4 < (i + 3) / 4; ++j4) av[j4] = *(const LAS f32x4*)(AM + i * 64 + j4 * 4);
                if (i + 1 < 64) {
#pragma unroll
                    for (int j4 = 0; j4 < ((i + 4) / 4 < 8 ? (i + 4) / 4 : 8); ++j4) an[j4] = *(const LAS f32x4*)(AM + (i + 1) * 64 + j4 * 4);
                }
                float s0 = 0.f, s1 = 0.f;
#pragma unroll
                for (int j4 = 0; j4 < (i + 3) / 4; ++j4) {
                    if (j4 * 4 + 0 < i) s0 = fmaf(av[j4][0], x[j4 * 4 + 0], s0);
                    if (j4 * 4 + 1 < i) s1 = fmaf(av[j4][1], x[j4 * 4 + 1], s1);
                    if (j4 * 4 + 2 < i) s0 = fmaf(av[j4][2], x[j4 * 4 + 2], s0);
                    if (j4 * 4 + 3 < i) s1 = fmaf(av[j4][3], x[j4 * 4 + 3], s1);
                }
                float xi = ((lane_o == i) ? 1.f : 0.f) - (s0 + s1);
                asm volatile("" : "+v"(xi) :: "memory");
                x[i] = xi;
#pragma unroll
                for (int j4 = 0; j4 < 8; ++j4) av[j4] = an[j4];
            }
            const float bt = Bt[lane], fu = bt, fw = bt * __expf(Gc[lane]);
            const int cs = dir ? 63 - lane : lane;
            LAS unsigned short* tw = (LAS unsigned short*)(lds + L_TW + dir * 9216 + cs * 2);
            LAS unsigned short* tu = (LAS unsigned short*)(lds + L_TU + dir * 9216 + cs * 2);
#pragma unroll
            for (int i = 0; i < 64; ++i) { const unsigned pw = pk2(x[i] * fw, x[i] * fu); tw[i * 72] = (unsigned short)pw; tu[i * 72] = (unsigned short)(pw >> 16); }
        }
        __syncthreads();
        {
            bf16x8 KA[2][2], VB[2][2];
#pragma unroll
            for (int tt = 0; tt < 2; ++tt)
#pragma unroll
                for (int kk = 0; kk < 2; ++kk) {
                    KA[tt][kk] = p3_tr_frag(lds + L_KTS, lane, 2 * wq + tt, kk);
                    VB[tt][kk] = p3_tr_frag(lds + L_VTS, lane, 2 * wq + tt, kk);
                }
#pragma unroll
            for (int i = 0; i < 4; ++i) {
                bf16x8 TB[2], TA[2];
#pragma unroll
                for (int kk = 0; kk < 2; ++kk) {
                    TB[kk] = *(const LAS bf16x8*)(lds + L_TW + dir * 9216 + (i * 16 + m16) * 144 + (kk * 32 + kg * 8) * 2);
                    TA[kk] = *(const LAS bf16x8*)(lds + L_TU + dir * 9216 + (i * 16 + m16) * 144 + (kk * 32 + kg * 8) * 2);
                }
                f32x4 a0 = {0.f, 0.f, 0.f, 0.f}, a1 = a0, u0 = a0, u1 = a0;
#pragma unroll
                for (int kk = 0; kk < 2; ++kk) { a0 = MFMA16(KA[0][kk], TB[kk], a0); a1 = MFMA16(KA[1][kk], TB[kk], a1); u0 = MFMA16(TA[kk], VB[0][kk], u0); u1 = MFMA16(TA[kk], VB[1][kk], u1); }
                *(bf16x8*)(ops + (i * 4 + wq) * 1024 + lane * 16) = pack8(a0, a1);
                *(f32x4*)(ops + 24576 + ((2 * wq) * 4 + i) * 1024 + lane * 16) = u0;
                *(f32x4*)(ops + 24576 + ((2 * wq + 1) * 4 + i) * 1024 + lane * 16) = u1;
            }
            if (wq == 1) {
                float* sc = (float*)(ops + 57344);
                const float gl = Gc[63], gc = Gc[lane];
                sc[lane] = __expf(gc); sc[64 + lane] = __expf(gl - gc);
                if (lane == 0) sc[128] = __expf(gl);
            }
        }
        __syncthreads();
    }
}

constexpr int SB_BYTES = 62464;
constexpr int X_OFF = 2 * SB_BYTES;
DI void scan_task(const Args& a, LAS unsigned char* lds, int bh, int dir, int dvt) {
    const int tid = otid(a.wv), lane = tid & 63, w = __builtin_amdgcn_readfirstlane(tid >> 6), m16 = lane & 15, kg = lane >> 4;
    const int b = bh >> 2, h = bh & 3;
    if (w < 4) {
        const int j = w;
        bf16_t* OD = (bf16_t*)a.out + (size_t)MTOK * 512 * (1 + dir);
        f32x4 S0 = {0.f, 0.f, 0.f, 0.f}, S1 = S0;
        LAS unsigned char* XL = lds + X_OFF + lane * 16;
        *(LAS bf16x8*)(XL + j * 1024) = pack8(S0, S1);
        for (int n = 0; n < 128; ++n) {
            LDS_WAIT(); __builtin_amdgcn_s_barrier(); asm volatile("" ::: "memory");
            const LAS unsigned char* B = lds + (n & 1) * SB_BYTES;
            const LAS unsigned char* BL = B + lane * 16;
            bf16x8 Sb[4];
#pragma unroll
            for (int kk = 0; kk < 4; ++kk) Sb[kk] = *(const LAS bf16x8*)(XL + kk * 1024);
            const f32x4 eg = *(const LAS f32x4*)(B + 28672 + (j * 16 + kg * 4) * 4), el = *(const LAS f32x4*)(B + 28672 + 256 + (j * 16 + kg * 4) * 4);
            const float egl = *(const LAS float*)(B + 28672 + 512);
            f32x4 acc = {0.f, 0.f, 0.f, 0.f}, o = acc;
#pragma unroll
            for (int kk = 0; kk < 4; ++kk) { acc = MFMA16(*(const LAS bf16x8*)(BL + (j * 4 + kk) * 1024), Sb[kk], acc); o = MFMA16(*(const LAS bf16x8*)(BL + 29696 + (j * 4 + kk) * 1024), Sb[kk], o); }
            const f32x4 vn = *(const LAS f32x4*)(BL + 24576 + j * 1024) - acc;
            const f32x4 vs = vn * el;
            { u32x2 vb = {pk2(vn[0], vn[1]), pk2(vn[2], vn[3])};
              *(LAS u32x2*)(XL + 6144 + (j >> 1) * 1024 + (j & 1) * 8) = vb;
              u32x2 vd; int off;
              if (!dir) { vd = (u32x2){pk2(vs[0], vs[1]), pk2(vs[2], vs[3])}; off = (j & 1) * 8; }
              else { vd = (u32x2){pk2(vs[3], vs[2]), pk2(vs[1], vs[0])}; off = (1 - (j & 1)) * 8; }
              *(LAS u32x2*)(XL + 4096 + (j >> 1) * 1024 + off) = vd; }
            o = o * eg;
            LDS_WAIT(); __builtin_amdgcn_s_barrier(); asm volatile("" ::: "memory");
            const bf16x8 Vd0 = *(const LAS bf16x8*)(XL + 4096), Vd1 = *(const LAS bf16x8*)(XL + 5120), Vb0 = *(const LAS bf16x8*)(XL + 6144), Vb1 = *(const LAS bf16x8*)(XL + 7168);
            S0 = S0 * egl; S1 = S1 * egl;
            S0 = MFMA16(*(const LAS bf16x8*)(BL + 46080 + (4 * j) * 1024), Vd0, S0); S1 = MFMA16(*(const LAS bf16x8*)(BL + 46080 + (4 * j + 2) * 1024), Vd0, S1);
            S0 = MFMA16(*(const LAS bf16x8*)(BL + 46080 + (4 * j + 1) * 1024), Vd1, S0); S1 = MFMA16(*(const LAS bf16x8*)(BL + 46080 + (4 * j + 3) * 1024), Vd1, S1);
            o = MFMA16(*(const LAS bf16x8*)(BL + 16384 + (2 * j) * 1024), Vb0, o);
            o = MFMA16(*(const LAS bf16x8*)(BL + 16384 + (2 * j + 1) * 1024), Vb1, o);
            *(LAS bf16x8*)(XL + j * 1024) = pack8(S0, S1);
            const int nc = dir ? 127 - n : n;
            const size_t tokb = (size_t)b * SEQ + nc * 64;
#pragma unroll
            for (int r = 0; r < 4; ++r) { const int c = j * 16 + kg * 4 + r; const size_t tok = tokb + (dir ? 63 - c : c);
                OD[tok * 512 + h * 128 + dvt * 16 + m16] = (bf16_t)pk2(o[r], 0.f); }
        }
    } else {
        const int li = w - 4;
        const unsigned char* OPS = a.ws + A_OPS; const bf16_t* QT = (const bf16_t*)a.out; const bf16_t* KTT = (const bf16_t*)(a.ws + A_KTT);
        const int nc0 = dir ? 127 : 0;
        const unsigned char* ops0 = OPS + (size_t)((bh * 128 + nc0) * 2 + dir) * OPS_TASK;
        const long st_ops = dir ? -2L * OPS_TASK : 2L * OPS_TASK, st_q = dir ? -65536L : 65536L, st_k = dir ? -128L : 128L;
        const unsigned char* ptr[16]; long stride[16]; unsigned ldso[16];
#pragma unroll
        for (int k = 0; k < 16; ++k) {
            const int u = min(li + 4 * k, 60); ldso[k] = (unsigned)(u * 1024 + lane * 16);
            const unsigned char* p = ops0; long st = st_ops;
            if (u < 24) p = ops0 + u * 1024 + lane * 16;
            else if (u < 28) p = ops0 + 24576 + (dvt * 4 + (u - 24)) * 1024 + lane * 16;
            else if (u == 28) p = ops0 + 57344 + lane * 16;
            else if (u < 45) { const int f = u - 29, i = f >> 2, kk = f & 3, c = i * 16 + m16; const size_t tok = (size_t)b * SEQ + nc0 * 64 + (dir ? 63 - c : c);
                p = (const unsigned char*)(QT + tok * 512 + h * 128 + kk * 32 + kg * 8); st = st_q; }
            else { const int f = u - 45, t = f >> 1, kk = f & 1, dk = t * 16 + m16; const int pos = nc0 * 64 + (dir ? (1 - kk) * 32 + (3 - kg) * 8 : kk * 32 + kg * 8);
                p = (const unsigned char*)(KTT + ((size_t)(bh * 128 + dk) * SEQ + pos)); st = st_k; }
            ptr[k] = p; stride[k] = st;
        }
        u32x4 R0[16], R1[16];
#pragma unroll
        for (int k = 0; k < 16; ++k) { R0[k] = *(GAS const u32x4*)ptr[k]; ptr[k] += stride[k]; }
#pragma unroll
        for (int k = 0; k < 16; ++k) { R1[k] = *(GAS const u32x4*)ptr[k]; ptr[k] += stride[k]; }
        for (int n = 0; n < 128; n += 2) {
            const long adv0 = (n + 3 < 128) ? 1L : 0L, adv1 = (n + 4 < 128) ? 1L : 0L;
#pragma unroll
            for (int k = 0; k < 16; ++k) *(LAS u32x4*)(lds + ldso[k]) = R0[k];
#pragma unroll
            for (int k = 0; k < 16; ++k) { R0[k] = *(GAS const u32x4*)ptr[k]; ptr[k] += stride[k] * adv0; }
            LDS_WAIT(); __builtin_amdgcn_s_barrier(); __builtin_amdgcn_s_barrier();
#pragma unroll
            for (int k = 0; k < 16; ++k) *(LAS u32x4*)(lds + SB_BYTES + ldso[k]) = R1[k];
#pragma unroll
            for (int k = 0; k < 16; ++k) { R1[k] = *(GAS const u32x4*)ptr[k]; ptr[k] += stride[k] * adv1; }
            LDS_WAIT(); __builtin_amdgcn_s_barrier(); __builtin_amdgcn_s_barrier();
        }
    }
    __syncthreads();
}

typedef GAS unsigned long long gu64; typedef GAS unsigned gu32;
#define RLX_AGENT __ATOMIC_RELAXED, __HIP_MEMORY_SCOPE_AGENT
DI void spin_ge(gu32* word, unsigned want, unsigned& seen) {
    if (seen >= want) return;
    unsigned sp = 0, v;
    while ((v = (unsigned)__builtin_amdgcn_readfirstlane(__hip_atomic_load(word, RLX_AGENT))) < want) { __builtin_amdgcn_s_sleep(1); if (++sp > (1u << 22)) break; }
    seen = v;
    asm volatile("" ::: "memory");
}
constexpr int SCAN_NT = 1;
template <int NT>
DI void scan_A(const Args& a, LAS unsigned char* lds, int t, int bh, int dir, int dvt0) {
    constexpr int SA = 16384 + NT * 4096 + 1024 + 16384, O_U = 16384, O_SC = 16384 + NT * 4096, O_KF = O_SC + 1024, NU = 33 + 4 * NT, NK = (NU + 2) / 3;
    constexpr int XA = 2 * SA, X_VD = NT * 4096, X_VB = NT * 4096 + NT * 2048;
    const int tid = otid(a.wv), lane = tid & 63, w = __builtin_amdgcn_readfirstlane(tid >> 6), m16 = lane & 15, kg = lane >> 4;
    LAS unsigned char* XL = lds + XA + lane * 16;
    if (w < 4) {
        const int j = w;
        f32x4 S0[NT], S1[NT];
#pragma unroll
        for (int e = 0; e < NT; ++e) { S0[e] = (f32x4){0.f, 0.f, 0.f, 0.f}; S1[e] = S0[e]; *(LAS bf16x8*)(XL + e * 4096 + j * 1024) = pack8(S0[e], S1[e]); }
        for (int n = 0; n < 128; ++n) {
            LDS_WAIT(); __builtin_amdgcn_s_barrier(); asm volatile("" ::: "memory");
            const LAS unsigned char* B = lds + (n & 1) * SA;
            const LAS unsigned char* BL = B + lane * 16;
            const f32x4 el = *(const LAS f32x4*)(B + O_SC + 256 + (j * 16 + kg * 4) * 4);
            const float egl = *(const LAS float*)(B + O_SC + 512);
            bf16x8 Wf[4];
#pragma unroll
            for (int kk = 0; kk < 4; ++kk) Wf[kk] = *(const LAS bf16x8*)(BL + (j * 4 + kk) * 1024);
#pragma unroll
            for (int e = 0; e < NT; ++e) {
                f32x4 acc = {0.f, 0.f, 0.f, 0.f};
#pragma unroll
                for (int kk = 0; kk < 4; ++kk) acc = MFMA16(Wf[kk], *(const LAS bf16x8*)(XL + e * 4096 + kk * 1024), acc);
                const f32x4 vn = *(const LAS f32x4*)(BL + O_U + e * 4096 + j * 1024) - acc;
                const f32x4 vs = vn * el;
                u32x2 vb = {pk2(vn[0], vn[1]), pk2(vn[2], vn[3])};
                *(LAS u32x2*)(XL + X_VB + e * 2048 + (j >> 1) * 1024 + (j & 1) * 8) = vb;
                u32x2 vd; int off;
                if (!dir) { vd = (u32x2){pk2(vs[0], vs[1]), pk2(vs[2], vs[3])}; off = (j & 1) * 8; }
                else { vd = (u32x2){pk2(vs[3], vs[2]), pk2(vs[1], vs[0])}; off = (1 - (j & 1)) * 8; }
                *(LAS u32x2*)(XL + X_VD + e * 2048 + (j >> 1) * 1024 + off) = vd;
            }
            LDS_WAIT(); __builtin_amdgcn_s_barrier(); asm volatile("" ::: "memory");
            bf16x8 Kf[4];
#pragma unroll
            for (int q = 0; q < 4; ++q) Kf[q] = *(const LAS bf16x8*)(BL + O_KF + (4 * j + q) * 1024);
#pragma unroll
            for (int e = 0; e < NT; ++e) {
                const bf16x8 Vd0 = *(const LAS bf16x8*)(XL + X_VD + e * 2048), Vd1 = *(const LAS bf16x8*)(XL + X_VD + e * 2048 + 1024);
                f32x4 s0 = S0[e] * egl, s1 = S1[e] * egl;
                s0 = MFMA16(Kf[0], Vd0, s0); s1 = MFMA16(Kf[2], Vd0, s1);
                s0 = MFMA16(Kf[1], Vd1, s0); s1 = MFMA16(Kf[3], Vd1, s1);
                S0[e] = s0; S1[e] = s1;
                *(LAS bf16x8*)(XL + e * 4096 + j * 1024) = pack8(s0, s1);
            }
        }
    } else if (w < 7) {
        const int li = w - 4;
        const unsigned char* OPS = a.ws + A_OPS; const bf16_t* KTT = (const bf16_t*)(a.ws + A_KTT);
        const int nc0 = dir ? 127 : 0;
        const unsigned char* ops0 = OPS + (size_t)((bh * 128 + nc0) * 2 + dir) * OPS_TASK;
        const long st_ops = dir ? -2L * OPS_TASK : 2L * OPS_TASK, st_k = dir ? -128L : 128L;
        const unsigned char* ptr[NK]; long stride[NK]; unsigned ldso[NK];
#pragma unroll
        for (int k = 0; k < NK; ++k) {
            const int u = min(li + 3 * k, NU - 1); ldso[k] = (unsigned)(u * 1024 + lane * 16);
            const unsigned char* p = ops0; long st = st_ops;
            if (u < 16) p = ops0 + u * 1024 + lane * 16;
            else if (u < 16 + 4 * NT) p = ops0 + 24576 + (dvt0 * 4 + (u - 16)) * 1024 + lane * 16;
            else if (u == 16 + 4 * NT) p = ops0 + 57344 + lane * 16;
            else { const int f = u - (17 + 4 * NT), tt = f >> 1, kk = f & 1, dk = tt * 16 + m16; const int pos = nc0 * 64 + (dir ? (1 - kk) * 32 + (3 - kg) * 8 : kk * 32 + kg * 8);
                p = (const unsigned char*)(KTT + ((size_t)(bh * 128 + dk) * SEQ + pos)); st = st_k; }
            ptr[k] = p; stride[k] = st;
        }
        constexpr int DA = 3;
        u32x4 R[DA][NK];
#pragma unroll
        for (int d = 0; d < DA; ++d)
#pragma unroll
            for (int k = 0; k < NK; ++k) { R[d][k] = *(GAS const u32x4*)ptr[k]; ptr[k] += stride[k]; }
        int n = 0;
        for (; n + DA <= 128; n += DA) {
#pragma unroll
            for (int sidx = 0; sidx < DA; ++sidx) {
                const int m = n + sidx; const unsigned bo = (m & 1) ? (unsigned)SA : 0u; const long adv = (m + DA + 1 < 128) ? 1L : 0L;
#pragma unroll
                for (int k = 0; k < NK; ++k) *(LAS u32x4*)(lds + bo + ldso[k]) = R[sidx][k];
#pragma unroll
                for (int k = 0; k < NK; ++k) { R[sidx][k] = *(GAS const u32x4*)ptr[k]; ptr[k] += stride[k] * adv; }
                LDS_WAIT(); __builtin_amdgcn_s_barrier(); __builtin_amdgcn_s_barrier();
            }
        }
#pragma unroll
        for (int sidx = 0; sidx < 128 % DA; ++sidx) {
            const int m = n + sidx; const unsigned bo = (m & 1) ? (unsigned)SA : 0u;
#pragma unroll
            for (int k = 0; k < NK; ++k) *(LAS u32x4*)(lds + bo + ldso[k]) = R[sidx][k];
            LDS_WAIT(); __builtin_amdgcn_s_barrier(); __builtin_amdgcn_s_barrier();
        }
    } else {
        gu32* prod = (gu32*)(a.ws + OFF_FLG) + 16 * t; gu32* ack = (gu32*)(a.ws + OFF_FLG + 8192) + 16 * t;
        unsigned char* ring = a.ws + OFF_RING + (size_t)t * RING_R * (RING_SLOT * NT);
        const __amdgpu_buffer_rsrc_t rrs = __builtin_amdgcn_make_buffer_rsrc(ring, 0, RING_R * RING_SLOT * NT, 0x00020000);
        unsigned ack_seen = 0u;
        for (int n = 0; n < 128; ++n) {
            __builtin_amdgcn_s_barrier(); asm volatile("" ::: "memory");
            u32x4 pv[6 * NT];
#pragma unroll
            for (int e = 0; e < NT; ++e)
#pragma unroll
                for (int kk = 0; kk < 4; ++kk) pv[e * 6 + kk] = *(const LAS u32x4*)(XL + e * 4096 + kk * 1024);
            LDS_WAIT(); __builtin_amdgcn_s_barrier(); asm volatile("" ::: "memory");
#pragma unroll
            for (int e = 0; e < NT; ++e) { pv[e * 6 + 4] = *(const LAS u32x4*)(XL + X_VB + e * 2048); pv[e * 6 + 5] = *(const LAS u32x4*)(XL + X_VB + e * 2048 + 1024); }
            LDS_WAIT();
            if (n >= 2) { if (NT == 1) asm volatile("s_waitcnt vmcnt(6)" ::: "memory"); else asm volatile("s_waitcnt vmcnt(12)" ::: "memory");
                if (lane == 0) __hip_atomic_store(prod, (unsigned)(n - 1), RLX_AGENT); }
            if (n >= RING_R) spin_ge(ack, (unsigned)(n - RING_R + 1), ack_seen);
            const unsigned so = (unsigned)(n % RING_R) * (unsigned)(RING_SLOT * NT) + (unsigned)lane * 16u;
#pragma unroll
            for (int f = 0; f < 6 * NT; ++f) __builtin_amdgcn_raw_buffer_store_b128(pv[f], rrs, so + f * 1024, 0, 16);
        }
        asm volatile("s_waitcnt vmcnt(0)" ::: "memory"); if (lane == 0) __hip_atomic_store(prod, 128u, RLX_AGENT);
    }
    __syncthreads();
}
template <int NT>
DI void scan_B(const Args& a, LAS unsigned char* lds, int t, int bh, int dir, int dvt0) {
    constexpr int SBB = 25600 + NT * 6144, NF = 6 * NT;
    const int tid = otid(a.wv), lane = tid & 63, w = __builtin_amdgcn_readfirstlane(tid >> 6), m16 = lane & 15, kg = lane >> 4;
    const int b = bh >> 2, h = bh & 3;
    if (w < 4) {
        const int j = w;
        bf16_t* OD = (bf16_t*)a.out + (size_t)MTOK * 512 * (1 + dir);
        for (int n = 0; n < 128; ++n) {
            __builtin_amdgcn_s_barrier(); asm volatile("" ::: "memory");
            const LAS unsigned char* B = lds + (n & 1) * SBB;
            const LAS unsigned char* BL = B + lane * 16;
            const f32x4 eg = *(const LAS f32x4*)(B + 24576 + (j * 16 + kg * 4) * 4);
            bf16x8 Qf[4], If[2];
#pragma unroll
            for (int kk = 0; kk < 4; ++kk) Qf[kk] = *(const LAS bf16x8*)(BL + (j * 4 + kk) * 1024);
            If[0] = *(const LAS bf16x8*)(BL + 16384 + (2 * j) * 1024); If[1] = *(const LAS bf16x8*)(BL + 16384 + (2 * j + 1) * 1024);
            const int nc = dir ? 127 - n : n;
            const size_t tokb = (size_t)b * SEQ + nc * 64;
#pragma unroll
            for (int e = 0; e < NT; ++e) {
                f32x4 o = {0.f, 0.f, 0.f, 0.f};
#pragma unroll
                for (int kk = 0; kk < 4; ++kk) o = MFMA16(Qf[kk], *(const LAS bf16x8*)(BL + 25600 + (e * 6 + kk) * 1024), o);
                o = o * eg;
                o = MFMA16(If[0], *(const LAS bf16x8*)(BL + 25600 + (e * 6 + 4) * 1024), o);
                o = MFMA16(If[1], *(const LAS bf16x8*)(BL + 25600 + (e * 6 + 5) * 1024), o);
#pragma unroll
                for (int r = 0; r < 4; ++r) { const int c = j * 16 + kg * 4 + r; const size_t tok = tokb + (dir ? 63 - c : c);
                    OD[tok * 512 + h * 128 + (dvt0 + e) * 16 + m16] = (bf16_t)pk2(o[r], 0.f); }
            }
            LDS_WAIT();
        }
    } else if (w < 7) {
        const int li = w - 4;
        const unsigned char* OPS = a.ws + A_OPS; const bf16_t* QT = (const bf16_t*)a.out;
        const int nc0 = dir ? 127 : 0;
        const unsigned char* ops0 = OPS + (size_t)((bh * 128 + nc0) * 2 + dir) * OPS_TASK;
        const long st_ops = dir ? -2L * OPS_TASK : 2L * OPS_TASK, st_q = dir ? -65536L : 65536L;
        const unsigned char* ptr[9]; long stride[9]; unsigned ldso[9];
#pragma unroll
        for (int k = 0; k < 9; ++k) {
            const int u = min(li + 3 * k, 24); ldso[k] = (unsigned)(u * 1024 + lane * 16);
            const unsigned char* p = ops0; long st = st_ops;
            if (u < 16) { const int i = u >> 2, kk = u & 3, c = i * 16 + m16; const size_t tok = (size_t)b * SEQ + nc0 * 64 + (dir ? 63 - c : c);
                p = (const unsigned char*)(QT + tok * 512 + h * 128 + kk * 32 + kg * 8); st = st_q; }
            else if (u < 24) p = ops0 + 16384 + (u - 16) * 1024 + lane * 16;
            else p = ops0 + 57344 + lane * 16;
            ptr[k] = p; stride[k] = st;
        }
        constexpr int DB = 4;
        u32x4 R[DB][9];
#pragma unroll
        for (int d = 0; d < DB; ++d)
#pragma unroll
            for (int k = 0; k < 9; ++k) { R[d][k] = *(GAS const u32x4*)ptr[k]; ptr[k] += stride[k]; }
        for (int n = 0; n < 128; n += DB) {
#pragma unroll
            for (int sidx = 0; sidx < DB; ++sidx) {
                const int m = n + sidx; const unsigned bo = (m & 1) ? (unsigned)SBB : 0u; const long adv = (m + DB + 1 < 128) ? 1L : 0L;
#pragma unroll
                for (int k = 0; k < 9; ++k) *(LAS u32x4*)(lds + bo + ldso[k]) = R[sidx][k];
#pragma unroll
                for (int k = 0; k < 9; ++k) { R[sidx][k] = *(GAS const u32x4*)ptr[k]; ptr[k] += stride[k] * adv; }
                LDS_WAIT(); __builtin_amdgcn_s_barrier();
            }
        }
    } else {
        gu32* prod = (gu32*)(a.ws + OFF_FLG) + 16 * t; gu32* ack = (gu32*)(a.ws + OFF_FLG + 8192) + 16 * t;
        const unsigned char* ring = a.ws + OFF_RING + (size_t)t * RING_R * (RING_SLOT * NT);
        constexpr int DC = 2;
        const __amdgpu_buffer_rsrc_t rrs = __builtin_amdgcn_make_buffer_rsrc((unsigned char*)ring, 0, RING_R * RING_SLOT * NT, 0x00020000);
        u32x4 P[DC][NF];
        unsigned prod_seen = 0u;
#pragma unroll
        for (int d = 0; d < DC; ++d) { spin_ge(prod, (unsigned)(d + 1), prod_seen);
#pragma unroll
            for (int f = 0; f < NF; ++f) P[d][f] = __builtin_amdgcn_raw_buffer_load_b128(rrs, (unsigned)d * (unsigned)(RING_SLOT * NT) + f * 1024 + (unsigned)lane * 16u, 0, 16); }
        for (int n = 0; n < 128; n += DC) {
#pragma unroll
            for (int sidx = 0; sidx < DC; ++sidx) {
                const int m = n + sidx; const unsigned bo = (m & 1) ? (unsigned)SBB : 0u;
#pragma unroll
                for (int f = 0; f < NF; ++f) *(LAS u32x4*)(lds + bo + 25600 + f * 1024 + lane * 16) = P[sidx][f];
                if (lane == 0) __hip_atomic_store(ack, (unsigned)(m + 1), RLX_AGENT);
                if (m + DC < 128) { spin_ge(prod, (unsigned)(m + DC + 1), prod_seen);
                    const unsigned so = (unsigned)((m + DC) % RING_R) * (unsigned)(RING_SLOT * NT) + (unsigned)lane * 16u;
#pragma unroll
                    for (int f = 0; f < NF; ++f) P[sidx][f] = __builtin_amdgcn_raw_buffer_load_b128(rrs, so + f * 1024, 0, 16); }
                LDS_WAIT(); __builtin_amdgcn_s_barrier();
            }
        }
    }
    __syncthreads();
}
DI void phase4(const Args& a, LAS unsigned char* lds) {
    if (gridDim.x == 256) {
        constexpr int TPX = 16 / SCAN_NT;
        const int x = blockIdx.x & 7, sl = blockIdx.x >> 3;
        if (sl < 2 * TPX) {
            const int t = x * TPX + (sl % TPX), grp = t / (8 / SCAN_NT), dvt0 = (t % (8 / SCAN_NT)) * SCAN_NT;
            if (sl < TPX) scan_A<SCAN_NT>(a, lds, t, grp >> 1, grp & 1, dvt0); else scan_B<SCAN_NT>(a, lds, t, grp >> 1, grp & 1, dvt0);
        }
        return;
    }
    for (int t = 0; t < 128; ++t) {
        const int owner = ((t >> 4) + 8 * (t & 15)) % (int)gridDim.x;
        if (owner != (int)blockIdx.x) continue;
        const int grp = t >> 3;
        scan_task(a, lds, grp >> 1, grp & 1, t & 7);
    }
}

DI void phase5(const Args& a) {
    const int tid = otid(a.wv), lane = tid & 63, w = tid >> 6;
    { const f32x4* p4 = (const f32x4*)a.in[1]; u32x2* pb = (u32x2*)(a.ws + OFF_PB);
      for (size_t i = (size_t)blockIdx.x * 512 + tid; i < (size_t)MTOK * PLE / 4; i += (size_t)gridDim.x * 512) { const f32x4 v = p4[i]; u32x2 o = {pk2(v[0], v[1]), pk2(v[2], v[3])}; pb[i] = o; } }
    const bf16_t* OF = (const bf16_t*)a.out + (size_t)MTOK * 512; const bf16_t* OB = OF + (size_t)MTOK * 512;
    const bf16_t* zg = (const bf16_t*)(a.ws + A_ZG); bf16_t* ydn = (bf16_t*)(a.ws + A_YDN);
    const float* gdn = a.in[10];
    const f32x4 g0 = *(const f32x4*)(gdn + (lane & 15) * 8), g1 = *(const f32x4*)(gdn + (lane & 15) * 8 + 4);
    for (int row = blockIdx.x * 8 + w; row < MTOK; row += gridDim.x * 8) {
        const u32x4 f = *(const u32x4*)(OF + (size_t)row * 512 + lane * 8), bb = *(const u32x4*)(OB + (size_t)row * 512 + lane * 8), z = *(const u32x4*)(zg + (size_t)row * 2560 + lane * 8);
        float o[8]; float ss = 0.f;
#pragma unroll
        for (int e = 0; e < 4; ++e) { o[2 * e] = bf_lo(f[e]) + bf_lo(bb[e]); o[2 * e + 1] = bf_hi(f[e]) + bf_hi(bb[e]); ss += o[2 * e] * o[2 * e] + o[2 * e + 1] * o[2 * e + 1]; }
        ss += __shfl_xor(ss, 1); ss += __shfl_xor(ss, 2); ss += __shfl_xor(ss, 4); ss += __shfl_xor(ss, 8);
        const float rstd = rsqrtf(ss * (1.0f / 128.0f) + EPS);
        u32x4 out;
#pragma unroll
        for (int e = 0; e < 4; ++e) { const float ga = e < 2 ? g0[2 * e] : g1[2 * e - 4], gb2 = e < 2 ? g0[2 * e + 1] : g1[2 * e - 3];
            out[e] = pk2(o[2 * e] * rstd * ga * bf_lo(z[e]), o[2 * e + 1] * rstd * gb2 * bf_hi(z[e])); }
        *(u32x4*)(ydn + (size_t)row * 512 + lane * 8) = out;
    }
}
DI void phase12(const Args& a) {
    const int tid = otid(a.wv), lane = tid & 63, w = tid >> 6;
    const float* rss3 = (const float*)(a.ws + OFF_RSS) + 2 * MTOK; const float* gf = a.in[20];
    for (int row = blockIdx.x * 8 + w; row < MTOK; row += gridDim.x * 8) {
        const float rstd = rsqrtf(rss3[row] * (1.0f / 1024.0f) + EPS);
        f32x4* o = (f32x4*)(a.out + (size_t)row * 1024) + lane;
#pragma unroll
        for (int j = 0; j < 4; ++j) { const f32x4 g = *((const f32x4*)gf + lane + 64 * j); f32x4 v = o[64 * j]; v = v * rstd * g; o[64 * j] = v; }
    }
}

#define XB_TMO      128
#define XB_XCNT(j)  (256  + 64 * (j))
#define XB_XSUB(j)  (1280 + 64 * (j))
#define XB_XGEN(j)  (2304 + 64 * (j))
#define XB_TOP      3328
#define XB_TOPGEN   3392
#define XCD_BAR_WORDS 3456
#define XB_SPIN_CAP (1u << 22)
DI unsigned xb_ld(unsigned* p) { return __hip_atomic_load(p, __ATOMIC_RELAXED, __HIP_MEMORY_SCOPE_AGENT); }
DI unsigned xb_add(unsigned* p, unsigned v) { return __hip_atomic_fetch_add(p, v, __ATOMIC_RELAXED, __HIP_MEMORY_SCOPE_AGENT); }
DI unsigned xb_xcc_id() { return (unsigned)__builtin_amdgcn_s_getreg((3 << 11) | 20) & 0xFu; }
#define XB_SPIN(cond, bar) do { unsigned _sp = 0; while (cond) { __builtin_amdgcn_s_sleep(1); \
    if ((++_sp & 255u) == 0u) { if (xb_ld(&(bar)[XB_TMO])) break; if (_sp > XB_SPIN_CAP) { atomicAdd(&(bar)[XB_TMO], 1u); break; } } } } while (0)
struct XcdBarrier { unsigned* bar; unsigned x; volatile LAS unsigned* st; bool leader; };
DI XcdBarrier xcd_barrier_post(unsigned* bar, volatile LAS unsigned* st) {
    XcdBarrier b; b.bar = bar; b.x = xb_xcc_id(); b.st = st; b.leader = threadIdx.x == 0;
    if (threadIdx.x == 0) (void)xb_add(&bar[XB_XCNT(b.x)], 1u);
    return b;
}
DI void xcd_barrier_complete(unsigned* bar, unsigned x, unsigned& nloc, unsigned& nx) {
    const unsigned G = gridDim.x * gridDim.y * gridDim.z;
    unsigned sum, cnt, mine, sp = 0u;
    for (;;) {
        sum = 0u; cnt = 0u; mine = 0u;
#pragma unroll
        for (unsigned j = 0; j < 16; ++j) { const unsigned c = xb_ld(&bar[XB_XCNT(j)]); sum += c; cnt += (c > 0u) ? 1u : 0u; mine = (j == x) ? c : mine; }
        if (sum == G) break;
        __builtin_amdgcn_s_sleep(1);
        if ((++sp & 255u) == 0u) { if (xb_ld(&bar[XB_TMO])) break; if (sp > XB_SPIN_CAP) { atomicAdd(&bar[XB_TMO], 1u); break; } }
    }
    nloc = mine > 0u ? mine : 1u; nx = cnt > 0u ? cnt : 1u;
}
DI void xcd_barrier(const XcdBarrier& b) {
    asm volatile("s_waitcnt vmcnt(0)" ::: "memory");
    __syncthreads();
    if (b.leader) {
        unsigned* bar = b.bar;
        __builtin_amdgcn_s_waitcnt(0);
        unsigned nloc = b.st[0], nx = b.st[1];
        if (nloc == 0u) { xcd_barrier_complete(bar, b.x, nloc, nx); b.st[0] = nloc; b.st[1] = nx; }
        const unsigned old = xb_add(&bar[XB_XSUB(b.x)], 1u);
        const unsigned gen = old / nloc;
        if (old + 1u == (gen + 1u) * nloc) {
            __builtin_amdgcn_fence(__ATOMIC_RELEASE, "agent");
            asm volatile("s_waitcnt vmcnt(0)" ::: "memory");
            const unsigned og = xb_add(&bar[XB_TOP], 1u);
            const unsigned tg = og / nx;
            if (og + 1u == (tg + 1u) * nx) xb_add(&bar[XB_TOPGEN], 1u);
            else XB_SPIN(xb_ld(&bar[XB_TOPGEN]) == tg, bar);
            __builtin_amdgcn_fence(__ATOMIC_ACQUIRE, "agent");
            xb_add(&bar[XB_XGEN(b.x)], 1u);
            asm volatile("s_waitcnt vmcnt(0)" ::: "memory");
        } else {
            XB_SPIN(xb_ld(&bar[XB_XGEN(b.x)]) == gen, bar);
            __builtin_amdgcn_fence(__ATOMIC_ACQUIRE, "agent");
            asm volatile("s_waitcnt vmcnt(0)" ::: "memory");
        }
    }
    __syncthreads();
}

typedef const __attribute__((address_space(4))) Args* KArgP;
DI Args load_args() {
#if defined(__HIP_DEVICE_COMPILE__)
    KArgP p = (KArgP)__builtin_amdgcn_kernarg_segment_ptr(); asm volatile("" : "+s"(p));
    Args r;
#pragma unroll
    for (int i = 0; i < 21; ++i) r.in[i] = p->in[i];
    r.out = p->out; r.ws = p->ws; r.ph_lo = p->ph_lo; r.ph_hi = p->ph_hi; r.wv = 0; r.pad_ = 0; return r;
#else
    return Args{};
#endif
}
__global__ __launch_bounds__(512, 2) void fwd_mega(Args a_in) {
    extern __shared__ __attribute__((aligned(16))) unsigned char smem[];
    LAS unsigned char* lds = (LAS unsigned char*)smem;
    cg::grid_group grid = cg::this_grid();
    const int ph_lo = a_in.ph_lo, ph_hi = a_in.ph_hi;
    const int wv_s = __builtin_amdgcn_readfirstlane((int)(threadIdx.x >> 6));
    volatile LAS unsigned* xst = (volatile LAS unsigned*)(lds + LDS_BYTES - 16);
    if (threadIdx.x == 0) { xst[0] = 0u; xst[1] = 0u; }
    __syncthreads();
    (void)xcd_barrier_post((unsigned*)(a_in.ws + OFF_BAR), xst);
    if (ph_lo < 0) grid.sync();
#define GRID_BARRIER() do { XcdBarrier xb_; xb_.bar = (unsigned*)(load_args().ws + OFF_BAR); xb_.x = xb_xcc_id(); xb_.st = (volatile LAS unsigned*)(lds + LDS_BYTES - 16); xb_.leader = (wv_s == 0) && (olane() == 0); xcd_barrier(xb_); } while (0)
#define RUN_PHASE(PH, ...) do { if (ph_lo <= (PH) && (PH) < ph_hi) { for (int rep_ = 0; rep_ < ((PROBE_PH == (PH)) ? 2 : 1); ++rep_) { { Args a = load_args(); a.wv = wv_s; unsigned char* ws = a.ws; float* rss = (float*)(ws + OFF_RSS); \
        const int G = osg((int)gridDim.x), c = osg((int)blockIdx.x); (void)ws; (void)rss; (void)G; (void)c; __VA_ARGS__ } if ((PH) + 1 < ph_hi || rep_ == 0 && PROBE_PH == (PH)) GRID_BARRIER(); } } } while (0)
    RUN_PHASE(0, phase0(a, lds););
    RUN_PHASE(1, { pg8::StaticOrder S; S.init(MTOK, NPROJ, G, c); pg8::Gemm g{(const bf16_t*)(ws + A_XN), (const bf16_t*)(ws + A_XN), (const bf16_t*)(ws + OFF_WIN), (const bf16_t*)(ws + OFF_WIN), 1024, 16, 16, a.wv};
            EpiProj E{(bf16_t*)(ws + A_PROJA), (bf16_t*)(ws + A_ZG), (float*)(ws + OFF_SMALL)}; pg8::gemm_phase(lds, g, S, E);
            if (G == 256 && c >= 192) { __syncthreads(); p0_weights(a, lds, P0_I_IN, P0_NIT, c - 192, 64); } });
    RUN_PHASE(2, phase2(a););
    RUN_PHASE(3, phase3(a, lds););
    RUN_PHASE(4, phase4(a, lds););
    RUN_PHASE(5, phase5(a););
    RUN_PHASE(6, { pg8::StaticOrder S; S.init(MTOK, 1024, G, c); pg8::Gemm g{(const bf16_t*)a.out + (size_t)3 * MTOK * 512, (const bf16_t*)(ws + A_YDN), (const bf16_t*)(ws + OFF_WAD), (const bf16_t*)(ws + OFF_WAD) + (size_t)1024 * 512, 512, 16, 8, a.wv};
            EpiMerge E{(const bf16_t*)(ws + A_ZG), (bf16_t*)(ws + A_MERGED)}; pg8::gemm_phase(lds, g, S, E); });
    RUN_PHASE(7, { pg8::StaticOrder S; S.init(MTOK, 1024, G, c); pg8::Gemm g{(const bf16_t*)(ws + A_MERGED), (const bf16_t*)(ws + A_MERGED), (const bf16_t*)(ws + OFF_WO), (const bf16_t*)(ws + OFF_WO), 1024, 16, 16, a.wv};
            if (G == 256) { EpiResidDrain<false> E{a.in[0], (bf16_t*)(ws + A_H1B), rss}; pg8::gemm_phase(lds, g, S, E); } else { EpiResid<false> E{a.in[0], (bf16_t*)(ws + A_H1B), rss}; pg8::gemm_phase(lds, g, S, E); } });
    RUN_PHASE(8, { pg8::StaticOrder S; S.init(MTOK, DFF, G, c); pg8::Gemm g{(const bf16_t*)(ws + A_H1B), (const bf16_t*)(ws + A_H1B), (const bf16_t*)(ws + OFF_W1), (const bf16_t*)(ws + OFF_W1), 1024, 16, 16, a.wv};
            Unit u0{-1, 0}; (void)S.next(0, u0);
            LAS float* tab = (LAS float*)(lds + pg8::STAGE_BYTES);
            { const int t_ = otid(a.wv); if (t_ < 256 && u0.pm >= 0) tab[t_] = rsqrtf(rss[u0.pm * 256 + t_] * (1.0f / 1024.0f) + EPS); }
            __syncthreads();
            EpiFF1 E{rss, (bf16_t*)(ws + A_ACT), tab, u0.pm}; pg8::gemm_phase(lds, g, S, E); });
    RUN_PHASE(9, { pg8::StaticOrder S; S.init(MTOK, 1024, G, c); pg8::Gemm g{(const bf16_t*)(ws + A_ACT), (const bf16_t*)(ws + A_ACT), (const bf16_t*)(ws + OFF_W2), (const bf16_t*)(ws + OFF_W2), 4096, 64, 64, a.wv};
            if (G == 256) { EpiResidDrain<true> E{(const void*)(ws + A_H1B), (bf16_t*)(ws + A_H2B), rss + MTOK}; pg8::gemm_phase(lds, g, S, E); } else { EpiResid<true> E{(const void*)(ws + A_H1B), (bf16_t*)(ws + A_H2B), rss + MTOK}; pg8::gemm_phase(lds, g, S, E); } });
    if (ph_lo <= 10 && 10 < ph_hi) for (int rep_ = 0; rep_ < ((PROBE_PH == 10) ? 2 : 1); ++rep_) { Args a = load_args(); a.wv = wv_s; unsigned char* ws = a.ws; const int G = osg((int)gridDim.x), c = osg((int)blockIdx.x);
        pg8::StaticOrder S; S.init(MTOK, 1024, G, c); pg8::Gemm g{(const bf16_t*)(ws + OFF_PB), (const bf16_t*)(ws + OFF_PB), (const bf16_t*)(ws + OFF_WPP), (const bf16_t*)(ws + OFF_WPP), 256, 4, 4, a.wv};
        EpiPP E{(bf16_t*)(ws + A_PP)}; pg8::gemm_phase(lds, g, S, E);
    }
    if (gridDim.x == 256) {
        if (ph_lo <= 11 && 11 < ph_hi) { Args a = load_args(); a.wv = wv_s; unsigned char* ws = a.ws; float* rss = (float*)(ws + OFF_RSS); const int G = osg((int)gridDim.x), c = osg((int)blockIdx.x);
            pg8::StaticOrder S; S.init(MTOK, 1024, G, c); pg8::Gemm g{(const bf16_t*)(ws + A_H2B), (const bf16_t*)(ws + A_H2B), (const bf16_t*)(ws + OFF_WPG), (const bf16_t*)(ws + OFF_WPG), 1024, 16, 16, a.wv};
            EpiGateFinal E{rss + MTOK, (const bf16_t*)(ws + A_PP), (const bf16_t*)(ws + A_H2B), a.out, rss + 2 * MTOK, (unsigned*)(ws + OFF_CNT), a.in[20], a.wv}; pg8::gemm_phase(lds, g, S, E); }
    } else {
        RUN_PHASE(11, { pg8::StaticOrder S; S.init(MTOK, 1024, G, c); pg8::Gemm g{(const bf16_t*)(ws + A_H2B), (const bf16_t*)(ws + A_H2B), (const bf16_t*)(ws + OFF_WPG), (const bf16_t*)(ws + OFF_WPG), 1024, 16, 16, a.wv};
                EpiGate E{rss + MTOK, (const bf16_t*)(ws + A_PP), (const bf16_t*)(ws + A_H2B), a.out, rss + 2 * MTOK}; pg8::gemm_phase(lds, g, S, E); });
        RUN_PHASE(12, phase12(a););
    }
    for (int i = 0; i < PROBE_SYNCS; ++i) GRID_BARRIER();
}

extern "C" void kernel_launch(void* const* d_in, const int* in_sizes, int n_in, void* d_out, int out_size, void* d_ws, size_t ws_size, hipStream_t stream) {
    static int grid = 0;
    if (grid == 0) {
        if (n_in != 21 || out_size != MTOK * DM || ws_size < WS_NEED) { fprintf(stderr, "kernel_launch: unexpected shapes (n_in %d out %d ws %zu)\n", n_in, out_size, ws_size); grid = -1; return; }
        int dev = 0, cus = 0, per_cu = 0;
        (void)hipGetDevice(&dev);
        (void)hipDeviceGetAttribute(&cus, hipDeviceAttributeMultiprocessorCount, dev);
        if (hipFuncSetAttribute((const void*)fwd_mega, hipFuncAttributeMaxDynamicSharedMemorySize, LDS_BYTES) != hipSuccess) { fprintf(stderr, "kernel_launch: hipFuncSetAttribute failed\n"); grid = -1; return; }
        if (hipOccupancyMaxActiveBlocksPerMultiprocessor(&per_cu, (const void*)fwd_mega, 512, LDS_BYTES) != hipSuccess || per_cu < 1) per_cu = 1;
        (void)hipGetLastError();
        grid = cus * per_cu;
        if (grid > 256) grid = 256;
        grid &= ~7;
        if (grid < 8) grid = 8;
    }
    if (grid < 0) return;
    Args a{};
    for (int i = 0; i < 21; ++i) a.in[i] = (const float*)d_in[i];
    a.out = (float*)d_out; a.ws = (unsigned char*)d_ws;
    if (hipMemsetAsync((unsigned char*)d_ws + OFF_BAR, 0, XCD_BAR_WORDS * 4, stream) != hipSuccess) { fprintf(stderr, "kernel_launch: memset of the barrier words failed\n"); return; }
#if MK_PER_PHASE
    for (int ph = 0; ph < NPHASE; ++ph) { a.ph_lo = ph; a.ph_hi = ph + 1; hipLaunchKernelGGL(fwd_mega, dim3(grid), dim3(512), LDS_BYTES, stream, a); }
#else
    a.ph_lo = 0; a.ph_hi = NPHASE;
    void* args[] = {&a};
    hipError_t e = hipLaunchCooperativeKernel((const void*)fwd_mega, dim3(grid), dim3(512), args, LDS_BYTES, stream);
    if (e != hipSuccess) fprintf(stderr, "cooperative launch failed: %s (grid %d)\n", hipGetErrorString(e), grid);
#endif
}
```

```cpp
#include <hip/hip_runtime.h>
#include <hip/hip_cooperative_groups.h>
#include <cstdio>
#include <cstdint>
namespace cg = cooperative_groups;

#ifndef PROBE_PH
#define PROBE_PH -1
#endif
#ifndef PROBE_EXTRA
#define PROBE_EXTRA 0
#endif
#ifndef PROBE_SYNCS
#define PROBE_SYNCS 0
#endif
#ifndef MK_PER_PHASE
#define MK_PER_PHASE 0
#endif

#define DI __device__ __forceinline__
#define LAS __attribute__((address_space(3)))
#define GAS __attribute__((address_space(1)))
typedef unsigned short bf16_t;
typedef short bf16x8 __attribute__((ext_vector_type(8)));
typedef float f32x4 __attribute__((ext_vector_type(4)));
typedef float f32x2 __attribute__((ext_vector_type(2)));
typedef unsigned u32x4 __attribute__((ext_vector_type(4)));
typedef unsigned u32x2 __attribute__((ext_vector_type(2)));
typedef __bf16 bf16v2 __attribute__((ext_vector_type(2)));

constexpr int MTOK = 16384, DM = 1024, SEQ = 8192, NH = 4, DFF = 4096, PLE = 256;
constexpr float EPS = 1e-6f;
constexpr int NPROJ = 5888;
constexpr int LDS_BYTES = 147456;
constexpr int NPHASE = 13;

constexpr size_t OFF_RSS = 0;
constexpr size_t OFF_BAR = 196608;
constexpr size_t OFF_CNT = 212992;
constexpr size_t OFF_FLG = 221184;
constexpr size_t OFF_WIN = 262144;
constexpr size_t OFF_WAD = OFF_WIN + 12058624;
constexpr size_t OFF_WO = OFF_WAD + 2097152;
constexpr size_t OFF_W1 = OFF_WO + 2097152;
constexpr size_t OFF_W2 = OFF_W1 + 8388608;
constexpr size_t OFF_WPG = OFF_W2 + 8388608;
constexpr size_t OFF_WPP = OFF_WPG + 2097152;
constexpr size_t OFF_PB = OFF_WPP + 524288;
constexpr size_t OFF_SMALL = OFF_PB + 8388608;
constexpr size_t OFF_GB = OFF_SMALL + 1048576;
constexpr size_t ARENA = OFF_GB + 1048576;
constexpr size_t A_ZG = ARENA;
constexpr size_t A_XN = ARENA + 83886080;
constexpr size_t A_PROJA = ARENA + 117440512;
constexpr size_t A_KTT = A_XN;
constexpr size_t A_OPS = ARENA + 100663296;
constexpr size_t A_YDN = A_OPS;
constexpr size_t A_TMP = ARENA + 117440512;
constexpr size_t A_MERGED = ARENA + 184549376;
constexpr size_t A_H1B = ARENA;
constexpr size_t A_ACT = ARENA + 33554432;
constexpr size_t A_H2B = ARENA + 167772160;
constexpr size_t A_PP = ARENA;
constexpr size_t OFF_RING = OFF_PB;
constexpr int RING_R = 13, RING_SLOT = 6144;
constexpr size_t WS_NEED = 268435456;
constexpr int OPS_TASK = 58368;

struct Args {
    const float* in[21];
    float* out;
    unsigned char* ws;
    int ph_lo, ph_hi;
    int wv, pad_;
};

DI unsigned pk2(float a, float b) { f32x2 v = {a, b}; return __builtin_bit_cast(unsigned, __builtin_convertvector(v, bf16v2)); }
DI float bf_lo(unsigned u) { return __uint_as_float(u << 16); }
DI float bf_hi(unsigned u) { return __uint_as_float(u & 0xffff0000u); }
DI float wave_sum(float v) {
#pragma unroll
    for (int o = 1; o < 64; o <<= 1) v += __shfl_xor(v, o);
    return v;
}
DI float sigmoidf_(float v) { return __builtin_amdgcn_rcpf(1.0f + __expf(-v)); }
DI bf16x8 pack8(f32x4 a, f32x4 b) { u32x4 p = {pk2(a[0], a[1]), pk2(a[2], a[3]), pk2(b[0], b[1]), pk2(b[2], b[3])}; return __builtin_bit_cast(bf16x8, p); }
DI bf16x8 pack8r(f32x4 a, f32x4 b) { u32x4 p = {pk2(a[3], a[2]), pk2(a[1], a[0]), pk2(b[3], b[2]), pk2(b[1], b[0])}; return __builtin_bit_cast(bf16x8, p); }
#define MFMA16(a, b, c) __builtin_amdgcn_mfma_f32_16x16x32_bf16((a), (b), (c), 0, 0, 0)
#define LDS_WAIT() asm volatile("s_waitcnt lgkmcnt(0)" ::: "memory")
DI int olane() { int l = (int)__builtin_amdgcn_mbcnt_hi(~0u, __builtin_amdgcn_mbcnt_lo(~0u, 0u)); asm volatile("" : "+v"(l)); return l; }
DI int otid(int wv) { int t = wv * 64 + olane(); asm volatile("" : "+v"(t)); return t; }
DI int osg(int v) { asm volatile("" : "+s"(v)); return v; }

namespace pg8 {
constexpr int BM = 256, BK = 64, HALF = 128, HTB = HALF * BK * 2, STAGE_BYTES = 8 * HTB, NXCD = 8, WGM = 8;
DI int lds_byte(int r, int c) { const int st = (r >> 4) * 2 + (c >> 5), rr = r & 15, cc = c & 31, ob = rr * 64 + cc * 2; return st * 1024 + (ob ^ (((ob >> 9) & 1) << 5)); }
DI void stage_rc(int b, int& R, int& C) { const int st = b / 1024, sb = b % 1024, swz = sb ^ (((sb >> 9) & 1) << 5); R = (st >> 1) * 16 + swz / 64; C = (st & 1) * 32 + (swz % 64) / 2; }
DI int perm32(int rho) { const int n = rho >> 4, i = rho & 15; return 8 * (i >> 2) + 4 * n + (i & 3); }

struct Unit { int pm, pn; };
struct Gemm { const bf16_t* A; const bf16_t* A2; const bf16_t* Bt; const bf16_t* Bt2; int ld; int nt; int nth; int wv; };

struct StaticOrder {
    int nM, nN, nwg, G, c;
    DI void init(int M, int N, int G_, int c_) { nM = M / BM; nN = N / BM; nwg = nM * nN; G = G_; c = c_; }
    DI bool tile(long L, Unit& u) const {
        if (L >= nwg) return false;
        int wgid = (int)L; { const int q = nwg / NXCD, r = nwg % NXCD, xcd = wgid % NXCD, off = wgid / NXCD; wgid = (xcd < r ? xcd * (q + 1) : r * (q + 1) + (xcd - r) * q) + off; }
        const int nig = WGM * nN, gid = wgid / nig, fm = gid * WGM, gsz = (nM - fm) < WGM ? (nM - fm) : WGM;
        u.pm = fm + ((wgid % nig) % gsz); u.pn = (wgid % nig) / gsz; return true;
    }
    DI bool next(int i, Unit& u) const { return tile((long)i * G + c, u); }
};
template <class Epi, class Sched>
DI void gemm_phase(LAS unsigned char* lds, const Gemm g, const Sched& S, const Epi& E) {
    const int tid = otid(g.wv), wid = __builtin_amdgcn_readfirstlane(tid >> 6), lane = tid & 63, wr = wid >> 2, wc = wid & 3, fr = lane & 15, fq = lane >> 4;
    const int K = g.ld, nt = g.nt, nth = g.nth;
    unsigned voffA[2], voffB[2];
#pragma unroll
    for (int i = 0; i < 2; ++i) { int R, C; stage_rc(tid * 16 + i * 8192, R, C); const int Rb = (R & ~31) + perm32(R & 31);
        voffA[i] = (unsigned)(R * K + C) * 2u; voffB[i] = (unsigned)(Rb * K + C) * 2u; }
    const size_t kstep = (size_t)(BK * 2);
    const size_t hstep = (size_t)HALF * K * 2;
    const size_t tstep = 2 * hstep;
    const unsigned ldsw = (unsigned)wid * 1024u;
    const int aoff = lds_byte(wr * 64 + fr, fq * 8), boff = lds_byte(wc * 32 + fr, fq * 8);
#define PG8_SA(b, h) (((b) * 2 + (h)) * HTB)
#define PG8_SB(b, h) ((4 + (b) * 2 + (h)) * HTB)
#define PG8_STAGE(bufoff, gbase, voff) do { _Pragma("unroll") for (int _i = 0; _i < 2; ++_i) \
        __builtin_amdgcn_global_load_lds((const unsigned*)((const char*)(gbase) + (voff)[_i]), (LAS unsigned*)(lds + (bufoff) + ldsw + _i * 8192), 16, 0, 0); } while (0)
#define PG8_LDA(dst, b, h) do { _Pragma("unroll") for (int m = 0; m < 4; ++m) _Pragma("unroll") for (int k = 0; k < 2; ++k) dst[m][k] = *(const LAS bf16x8*)(lds + PG8_SA(b, h) + aoff + m * 2048 + k * 1024); } while (0)
#define PG8_LDB(dst, b, h) do { _Pragma("unroll") for (int n = 0; n < 2; ++n) _Pragma("unroll") for (int k = 0; k < 2; ++k) dst[n][k] = *(const LAS bf16x8*)(lds + PG8_SB(b, h) + boff + n * 2048 + k * 1024); } while (0)
#define PG8_MMA(ai, bj, At, Bt) do { __builtin_amdgcn_s_setprio(1); _Pragma("unroll") for (int m = 0; m < 4; ++m) _Pragma("unroll") for (int n = 0; n < 2; ++n) _Pragma("unroll") for (int k = 0; k < 2; ++k) \
        acc[ai][bj][m][n] = __builtin_amdgcn_mfma_f32_16x16x32_bf16(Bt[n][k], At[m][k], acc[ai][bj][m][n], 0, 0, 0); __builtin_amdgcn_s_setprio(0); } while (0)
#define PG8_WAIT_V(n) asm volatile("s_waitcnt vmcnt(" #n ")" ::: "memory")
#define PG8_WAIT_L(n) asm volatile("s_waitcnt lgkmcnt(" #n ")" ::: "memory")
#define PG8_BAR __builtin_amdgcn_s_barrier()
#define PG8_SCHED __builtin_amdgcn_sched_barrier(0)
    Unit cur, nxt; int ui = 0;
    if (!S.next(0, cur)) return;
    f32x4 acc[2][2][4][2];
#pragma unroll
    for (int a = 0; a < 2; ++a)
#pragma unroll
        for (int b = 0; b < 2; ++b)
#pragma unroll
            for (int m = 0; m < 4; ++m)
#pragma unroll
                for (int n = 0; n < 2; ++n) acc[a][b][m][n] = (f32x4){0.f, 0.f, 0.f, 0.f};
    bf16x8 At[4][2], B0[2][2], B1[2][2];
    const char* cA = (const char*)g.A + (size_t)cur.pm * tstep; const char* cB = (const char*)g.Bt + (size_t)cur.pn * tstep;
    const long dA2 = (const char*)g.A2 - (const char*)g.A - (long)nth * (long)kstep, dB2 = (const char*)g.Bt2 - (const char*)g.Bt - (long)nth * (long)kstep;
    PG8_STAGE(PG8_SB(0, 0), cB, voffB); PG8_STAGE(PG8_SA(0, 0), cA, voffA); PG8_STAGE(PG8_SB(0, 1), cB + hstep, voffB); PG8_STAGE(PG8_SA(0, 1), cA + hstep, voffA);
    if (wr == 1) PG8_BAR;
    PG8_WAIT_V(4); PG8_BAR;
    PG8_STAGE(PG8_SB(1, 0), cB + kstep, voffB); PG8_STAGE(PG8_SA(1, 0), cA + kstep, voffA); PG8_STAGE(PG8_SB(1, 1), cB + hstep + kstep, voffB);
    PG8_WAIT_V(6); PG8_BAR;
    for (;;) {
        const bool has_next = S.next(ui + 1, nxt);
        const char* nA = has_next ? (const char*)g.A + (size_t)nxt.pm * tstep : cA; const char* nB = has_next ? (const char*)g.Bt + (size_t)nxt.pn * tstep : cB;
        for (int t = 0; t < nt; t += 2) {
            const bool last = (t == nt - 2);
            if constexpr (Epi::HAS_MID) { if (t == nth) { const int l2 = olane(); E.mid(acc, cur, wr, wc, l2 & 15, l2 >> 4); PG8_SCHED; } }
            const char* a1 = cA + (size_t)(t + 1) * kstep + (t + 1 >= nth ? dA2 : 0L);
            const char* a2 = last ? nA : cA + (size_t)(t + 2) * kstep + (t + 2 >= nth ? dA2 : 0L); const char* b2 = last ? nB : cB + (size_t)(t + 2) * kstep + (t + 2 >= nth ? dB2 : 0L);
            const char* a3 = a2 + kstep; const char* b3 = b2 + kstep;
            PG8_LDB(B0, 0, 0); PG8_SCHED; PG8_LDA(At, 0, 0); PG8_STAGE(PG8_SA(1, 1), a1 + hstep, voffA);
            PG8_WAIT_L(8); PG8_BAR; PG8_WAIT_L(0); PG8_MMA(0, 0, At, B0); PG8_BAR; PG8_SCHED;
            PG8_LDB(B1, 0, 1); PG8_STAGE(PG8_SB(0, 0), b2, voffB);
            PG8_BAR; PG8_WAIT_L(0); PG8_MMA(0, 1, At, B1); PG8_BAR;
            PG8_LDA(At, 0, 1); PG8_STAGE(PG8_SA(0, 0), a2, voffA);
            PG8_BAR; PG8_WAIT_L(0); PG8_MMA(1, 0, At, B0); PG8_BAR; PG8_SCHED;
            PG8_STAGE(PG8_SB(0, 1), b2 + hstep, voffB);
            PG8_WAIT_V(6); PG8_BAR; PG8_MMA(1, 1, At, B1); PG8_BAR;
            PG8_LDB(B0, 1, 0); PG8_SCHED; PG8_LDA(At, 1, 0); PG8_STAGE(PG8_SA(0, 1), a2 + hstep, voffA);
            PG8_WAIT_L(8); PG8_BAR; PG8_WAIT_L(0); PG8_MMA(0, 0, At, B0); PG8_BAR; PG8_SCHED;
            PG8_LDB(B1, 1, 1); PG8_STAGE(PG8_SB(1, 0), b3, voffB);
            PG8_BAR; PG8_WAIT_L(0); PG8_MMA(0, 1, At, B1); PG8_BAR;
            PG8_LDA(At, 1, 1); PG8_STAGE(PG8_SA(1, 0), a3, voffA);
            PG8_BAR; PG8_WAIT_L(0); PG8_MMA(1, 0, At, B0); PG8_BAR; PG8_SCHED;
            PG8_STAGE(PG8_SB(1, 1), b3 + hstep, voffB);
            PG8_WAIT_V(6); PG8_BAR; PG8_MMA(1, 1, At, B1); PG8_BAR;
        }
        if constexpr (!Epi::AFTER_DRAIN) { const int l2 = olane(); E(acc, cur, wr, wc, l2 & 15, l2 >> 4); }
        if (!has_next) break;
#pragma unroll
        for (int a = 0; a < 2; ++a)
#pragma unroll
            for (int b = 0; b < 2; ++b)
#pragma unroll
                for (int m = 0; m < 4; ++m)
#pragma unroll
                    for (int n = 0; n < 2; ++n) acc[a][b][m][n] = (f32x4){0.f, 0.f, 0.f, 0.f};
        cur = nxt; cA = nA; cB = nB; ++ui;
    }
    PG8_WAIT_V(0);
    if (wr == 0) PG8_BAR;
    PG8_BAR;
    if constexpr (Epi::AFTER_DRAIN) { const int l2 = olane(); E.fused(acc, cur, wr, wc, l2 & 15, l2 >> 4, lds); }
#undef PG8_SA
#undef PG8_SB
#undef PG8_STAGE
#undef PG8_LDA
#undef PG8_LDB
#undef PG8_MMA
#undef PG8_WAIT_V
#undef PG8_WAIT_L
#undef PG8_BAR
#undef PG8_SCHED
}
}
using pg8::Unit;
typedef f32x4 AccT[2][2][4][2];

DI void rowss_add(float* rss, int row, float s, int fq) {
    s += __shfl_xor(s, 16); s += __shfl_xor(s, 32);
    if (fq == 0) atomicAdd(rss + row, s);
}

struct EpiProj {
    static constexpr bool HAS_MID = false;
    static constexpr bool AFTER_DRAIN = false;
    bf16_t* proja; bf16_t* zg; float* small;
    DI void operator()(const AccT& acc, const Unit& u, int wr, int wc, int fr, int fq) const {
        const int row0 = u.pm * 256 + wr * 64 + fr, pn = u.pn;
        if (pn == 22) {
            if (wc == 0 && fq < 2) {
#pragma unroll
                for (int ai = 0; ai < 2; ++ai)
#pragma unroll
                    for (int m = 0; m < 4; ++m) { float* d = small + (size_t)(row0 + ai * 128 + m * 16) * 16 + 8 * fq;
                        *(f32x4*)d = acc[ai][0][m][0]; *(f32x4*)(d + 4) = acc[ai][0][m][1]; }
            }
            return;
        }
        bf16_t* base; int ld, colt, act;
        if (pn < 12) { base = proja; ld = 3072; colt = pn * 256; act = 0; }
        else if (pn < 14) { base = zg; ld = 2560; colt = (pn - 12) * 256; act = 1; }
        else { base = zg; ld = 2560; colt = 512 + (pn - 14) * 256; act = 2; }
#pragma unroll
        for (int ai = 0; ai < 2; ++ai)
#pragma unroll
            for (int m = 0; m < 4; ++m) { bf16_t* rowp = base + (size_t)(row0 + ai * 128 + m * 16) * ld + colt + wc * 32 + 8 * fq;
#pragma unroll
                for (int bj = 0; bj < 2; ++bj) { f32x4 v0 = acc[ai][bj][m][0], v1 = acc[ai][bj][m][1];
                    if (act) {
#pragma unroll
                        for (int j = 0; j < 4; ++j) { const float s0 = sigmoidf_(v0[j]), s1 = sigmoidf_(v1[j]); v0[j] = act == 1 ? v0[j] * s0 : s0; v1[j] = act == 1 ? v1[j] * s1 : s1; } }
                    u32x4 w = {pk2(v0[0], v0[1]), pk2(v0[2], v0[3]), pk2(v1[0], v1[1]), pk2(v1[2], v1[3])};
                    *(u32x4*)(rowp + bj * 128) = w; } }
    }
};
struct EpiMerge {
    static constexpr bool HAS_MID = true;
    static constexpr bool AFTER_DRAIN = false;
    const bf16_t* zg; bf16_t* merged;
    DI void mid(AccT& acc, const Unit& u, int wr, int wc, int fr, int fq) const {
        const int row0 = u.pm * 256 + wr * 64 + fr, col0 = u.pn * 256 + wc * 32 + 8 * fq;
#pragma unroll
        for (int ai = 0; ai < 2; ++ai)
#pragma unroll
            for (int m = 0; m < 4; ++m) { const size_t row = row0 + ai * 128 + m * 16;
                asm volatile("" ::: "memory");
#pragma unroll
                for (int bj = 0; bj < 2; ++bj) { const int col = col0 + bj * 128;
                    const u32x4 ga = *(const u32x4*)(zg + row * 2560 + 512 + col), gd = *(const u32x4*)(zg + row * 2560 + 1536 + col);
#pragma unroll
                    for (int e = 0; e < 4; ++e) { const float r0 = bf_lo(ga[e]) * __builtin_amdgcn_rcpf(fmaxf(bf_lo(gd[e]), 1e-30f)), r1 = bf_hi(ga[e]) * __builtin_amdgcn_rcpf(fmaxf(bf_hi(gd[e]), 1e-30f));
                        acc[ai][bj][m][e >> 1][(e & 1) * 2] *= r0; acc[ai][bj][m][e >> 1][(e & 1) * 2 + 1] *= r1; } } }
    }
    DI void operator()(const AccT& acc, const Unit& u, int wr, int wc, int fr, int fq) const {
        const int row0 = u.pm * 256 + wr * 64 + fr, col0 = u.pn * 256 + wc * 32 + 8 * fq;
#pragma unroll
        for (int ai = 0; ai < 2; ++ai)
#pragma unroll
            for (int m = 0; m < 4; ++m) { const size_t row = row0 + ai * 128 + m * 16;
#pragma unroll
                for (int bj = 0; bj < 2; ++bj) { const int col = col0 + bj * 128;
                    const u32x4 gw = *(const u32x4*)(zg + row * 2560 + 1536 + col);
                    const f32x4 g0 = {fmaxf(bf_lo(gw[0]), 1e-30f), fmaxf(bf_hi(gw[0]), 1e-30f), fmaxf(bf_lo(gw[1]), 1e-30f), fmaxf(bf_hi(gw[1]), 1e-30f)}, g1 = {fmaxf(bf_lo(gw[2]), 1e-30f), fmaxf(bf_hi(gw[2]), 1e-30f), fmaxf(bf_lo(gw[3]), 1e-30f), fmaxf(bf_hi(gw[3]), 1e-30f)};
                    const f32x4 v0 = acc[ai][bj][m][0] * g0, v1 = acc[ai][bj][m][1] * g1;
                    u32x4 w = {pk2(v0[0], v0[1]), pk2(v0[2], v0[3]), pk2(v1[0], v1[1]), pk2(v1[2], v1[3])};
                    *(u32x4*)(merged + row * 1024 + col) = w; } }
    }
};
template <bool BASE_BF16>
struct EpiResid {
    static constexpr bool HAS_MID = false;
    static constexpr bool AFTER_DRAIN = false;
    const void* base; bf16_t* hb; float* rss;
    DI void operator()(const AccT& acc, const Unit& u, int wr, int wc, int fr, int fq) const {
        const int row0 = u.pm * 256 + wr * 64 + fr, col0 = u.pn * 256 + wc * 32 + 8 * fq;
#pragma unroll
        for (int ai = 0; ai < 2; ++ai)
#pragma unroll
            for (int m = 0; m < 4; ++m) { const size_t row = row0 + ai * 128 + m * 16; float ss = 0.f;
#pragma unroll
                for (int bj = 0; bj < 2; ++bj) { const size_t o = row * 1024 + col0 + bj * 128;
                    f32x4 b0, b1;
                    if (BASE_BF16) { const u32x4 bw = *(const u32x4*)((const bf16_t*)base + o); b0 = (f32x4){bf_lo(bw[0]), bf_hi(bw[0]), bf_lo(bw[1]), bf_hi(bw[1])}; b1 = (f32x4){bf_lo(bw[2]), bf_hi(bw[2]), bf_lo(bw[3]), bf_hi(bw[3])}; }
                    else { b0 = *(const f32x4*)((const float*)base + o); b1 = *(const f32x4*)((const float*)base + o + 4); }
                    const f32x4 v0 = b0 + acc[ai][bj][m][0], v1 = b1 + acc[ai][bj][m][1];
                    u32x4 w = {pk2(v0[0], v0[1]), pk2(v0[2], v0[3]), pk2(v1[0], v1[1]), pk2(v1[2], v1[3])};
                    *(u32x4*)(hb + o) = w;
#pragma unroll
                    for (int j = 0; j < 4; ++j) ss += v0[j] * v0[j] + v1[j] * v1[j]; }
                rowss_add(rss, (int)row, ss, fq); }
    }
};
template <bool BASE_BF16>
struct EpiResidDrain {
    static constexpr bool HAS_MID = false;
    static constexpr bool AFTER_DRAIN = true;
    const void* base; bf16_t* hb; float* rss;
    DI void operator()(const AccT&, const Unit&, int, int, int, int) const {}
    DI void fused(AccT& acc, const Unit& u, int wr, int wc, int fr, int fq, LAS unsigned char* lds) const {
        const int row0 = u.pm * 256 + wr * 64 + fr, col0 = u.pn * 256 + wc * 32 + 8 * fq;
        LAS float* PS = (LAS float*)lds;
#pragma unroll
        for (int ai = 0; ai < 2; ++ai)
#pragma unroll
            for (int m = 0; m < 4; ++m) { const size_t row = row0 + ai * 128 + m * 16; float ss = 0.f;
#pragma unroll
                for (int bj = 0; bj < 2; ++bj) { const size_t o = row * 1024 + col0 + bj * 128;
                    f32x4 b0, b1;
                    if (BASE_BF16) { const u32x4 bw = *(const u32x4*)((const bf16_t*)base + o); b0 = (f32x4){bf_lo(bw[0]), bf_hi(bw[0]), bf_lo(bw[1]), bf_hi(bw[1])}; b1 = (f32x4){bf_lo(bw[2]), bf_hi(bw[2]), bf_lo(bw[3]), bf_hi(bw[3])}; }
                    else { b0 = *(const f32x4*)((const float*)base + o); b1 = *(const f32x4*)((const float*)base + o + 4); }
                    const f32x4 v0 = b0 + acc[ai][bj][m][0], v1 = b1 + acc[ai][bj][m][1];
                    u32x4 w = {pk2(v0[0], v0[1]), pk2(v0[2], v0[3]), pk2(v1[0], v1[1]), pk2(v1[2], v1[3])};
                    *(u32x4*)(hb + o) = w;
#pragma unroll
                    for (int j = 0; j < 4; ++j) ss += v0[j] * v0[j] + v1[j] * v1[j]; }
                ss += __shfl_xor(ss, 16); ss += __shfl_xor(ss, 32);
                if (fq == 0) PS[(ai * 128 + wr * 64 + m * 16 + fr) * 4 + wc] = ss; }
        __syncthreads();
        const int t_ = (wr * 4 + wc) * 64 + fq * 16 + fr;
        if (t_ < 256) { const f32x4 p4 = *(const LAS f32x4*)(PS + t_ * 4); atomicAdd(rss + u.pm * 256 + t_, (p4[0] + p4[1]) + (p4[2] + p4[3])); }
    }
};
struct EpiFF1 {
    static constexpr bool HAS_MID = false;
    static constexpr bool AFTER_DRAIN = false;
    const float* rss; bf16_t* act;
    DI void operator()(const AccT& acc, const Unit& u, int wr, int wc, int fr, int fq) const {
        const int row0 = u.pm * 256 + wr * 64 + fr, col0 = u.pn * 256 + wc * 32 + 8 * fq;
#pragma unroll
        for (int ai = 0; ai < 2; ++ai)
#pragma unroll
            for (int m = 0; m < 4; ++m) { const size_t row = row0 + ai * 128 + m * 16; const float rstd = rsqrtf(rss[row] * (1.0f / 1024.0f) + EPS);
#pragma unroll
                for (int bj = 0; bj < 2; ++bj) { f32x4 v0 = acc[ai][bj][m][0] * rstd, v1 = acc[ai][bj][m][1] * rstd;
#pragma unroll
                    for (int j = 0; j < 4; ++j) { const float a0 = fmaxf(v0[j], 0.f), a1 = fmaxf(v1[j], 0.f); v0[j] = a0 * a0; v1[j] = a1 * a1; }
                    u32x4 w = {pk2(v0[0], v0[1]), pk2(v0[2], v0[3]), pk2(v1[0], v1[1]), pk2(v1[2], v1[3])};
                    *(u32x4*)(act + row * 4096 + col0 + bj * 128) = w; } }
    }
};
struct EpiPP {
    static constexpr bool HAS_MID = false;
    static constexpr bool AFTER_DRAIN = false;
    bf16_t* pp;
    DI void operator()(const AccT& acc, const Unit& u, int wr, int wc, int fr, int fq) const {
        const int row0 = u.pm * 256 + wr * 64 + fr, col0 = u.pn * 256 + wc * 32 + 8 * fq;
#pragma unroll
        for (int ai = 0; ai < 2; ++ai)
#pragma unroll
            for (int m = 0; m < 4; ++m) { const size_t row = row0 + ai * 128 + m * 16;
#pragma unroll
                for (int bj = 0; bj < 2; ++bj) { const f32x4 v0 = acc[ai][bj][m][0], v1 = acc[ai][bj][m][1];
                    u32x4 w = {pk2(v0[0], v0[1]), pk2(v0[2], v0[3]), pk2(v1[0], v1[1]), pk2(v1[2], v1[3])};
                    *(u32x4*)(pp + row * 1024 + col0 + bj * 128) = w; } }
    }
};
struct EpiGate {
    static constexpr bool HAS_MID = false;
    static constexpr bool AFTER_DRAIN = false;
    const float* rss2; const bf16_t* pp; const bf16_t* hin; float* h; float* rss3;
    DI void operator()(const AccT& acc, const Unit& u, int wr, int wc, int fr, int fq) const {
        const int row0 = u.pm * 256 + wr * 64 + fr, col0 = u.pn * 256 + wc * 32 + 8 * fq;
#pragma unroll
        for (int ai = 0; ai < 2; ++ai)
#pragma unroll
            for (int m = 0; m < 4; ++m) { const size_t row = row0 + ai * 128 + m * 16; const float rstd = rsqrtf(rss2[row] * (1.0f / 1024.0f) + EPS); float ss = 0.f;
#pragma unroll
                for (int bj = 0; bj < 2; ++bj) { const size_t o = row * 1024 + col0 + bj * 128;
                    const u32x4 pw = *(const u32x4*)(pp + o);
                    const f32x4 p0 = {bf_lo(pw[0]), bf_hi(pw[0]), bf_lo(pw[1]), bf_hi(pw[1])}, p1 = {bf_lo(pw[2]), bf_hi(pw[2]), bf_lo(pw[3]), bf_hi(pw[3])};
                    const u32x4 hw = *(const u32x4*)(hin + o);
                    f32x4 v0 = {bf_lo(hw[0]), bf_hi(hw[0]), bf_lo(hw[1]), bf_hi(hw[1])}, v1 = {bf_lo(hw[2]), bf_hi(hw[2]), bf_lo(hw[3]), bf_hi(hw[3])};
#pragma unroll
                    for (int j = 0; j < 4; ++j) { v0[j] += sigmoidf_(acc[ai][bj][m][0][j] * rstd) * p0[j]; v1[j] += sigmoidf_(acc[ai][bj][m][1][j] * rstd) * p1[j]; ss += v0[j] * v0[j] + v1[j] * v1[j]; }
                    *(f32x4*)(h + o) = v0; *(f32x4*)(h + o + 4) = v1; }
                rowss_add(rss3, (int)row, ss, fq); }
    }
};

struct EpiGateFinal {
    static constexpr bool HAS_MID = false;
    static constexpr bool AFTER_DRAIN = true;
    const float* rss2; const bf16_t* pp; const bf16_t* h; float* out; float* rss3; unsigned* cnt; const float* gfin; int wv;
    DI void operator()(const AccT&, const Unit&, int, int, int, int) const {}
    DI void fused(AccT& acc, const Unit& u, int wr, int wc, int fr, int fq, LAS unsigned char* lds) const {
        const int row0 = u.pm * 256 + wr * 64 + fr, col0 = u.pn * 256 + wc * 32 + 8 * fq;
        LAS float* PS = (LAS float*)lds;
#pragma unroll
        for (int ai = 0; ai < 2; ++ai)
#pragma unroll
            for (int m = 0; m < 4; ++m) { const size_t row = row0 + ai * 128 + m * 16; const float rstd = rsqrtf(rss2[row] * (1.0f / 1024.0f) + EPS); float ss = 0.f;
#pragma unroll
                for (int bj = 0; bj < 2; ++bj) { const size_t o = row * 1024 + col0 + bj * 128;
                    const u32x4 pw = *(const u32x4*)(pp + o);
                    const f32x4 p0 = {bf_lo(pw[0]), bf_hi(pw[0]), bf_lo(pw[1]), bf_hi(pw[1])}, p1 = {bf_lo(pw[2]), bf_hi(pw[2]), bf_lo(pw[3]), bf_hi(pw[3])};
                    const u32x4 hw = *(const u32x4*)(h + o);
                    f32x4 v0 = {bf_lo(hw[0]), bf_hi(hw[0]), bf_lo(hw[1]), bf_hi(hw[1])}, v1 = {bf_lo(hw[2]), bf_hi(hw[2]), bf_lo(hw[3]), bf_hi(hw[3])};
#pragma unroll
                    for (int j = 0; j < 4; ++j) { v0[j] += sigmoidf_(acc[ai][bj][m][0][j] * rstd) * p0[j]; v1[j] += sigmoidf_(acc[ai][bj][m][1][j] * rstd) * p1[j]; ss += v0[j] * v0[j] + v1[j] * v1[j]; }
                    acc[ai][bj][m][0] = v0; acc[ai][bj][m][1] = v1; }
                ss += __shfl_xor(ss, 16); ss += __shfl_xor(ss, 32);
                if (fq == 0) PS[(ai * 128 + wr * 64 + m * 16 + fr) * 4 + wc] = ss; }
        __syncthreads();
        { const int t_ = (wr * 4 + wc) * 64 + fq * 16 + fr;
          if (t_ < 256) { const f32x4 p4 = *(const LAS f32x4*)(PS + t_ * 4); atomicAdd(rss3 + u.pm * 256 + t_, (p4[0] + p4[1]) + (p4[2] + p4[3])); } }
        asm volatile("s_waitcnt vmcnt(0)" ::: "memory");
        __syncthreads();
        if (wv == 0 && olane() == 0) {
            __hip_atomic_fetch_add(cnt + 16 * u.pm, 1u, __ATOMIC_RELEASE, __HIP_MEMORY_SCOPE_AGENT);
            unsigned sp = 0;
            while (__hip_atomic_load(cnt + 16 * u.pm, __ATOMIC_RELAXED, __HIP_MEMORY_SCOPE_AGENT) < 4u) { __builtin_amdgcn_s_sleep(1); if (++sp > (1u << 22)) break; }
            __builtin_amdgcn_fence(__ATOMIC_ACQUIRE, "agent");
            asm volatile("s_waitcnt vmcnt(0)" ::: "memory");
        }
        __syncthreads();
#pragma unroll
        for (int ai = 0; ai < 2; ++ai)
#pragma unroll
            for (int m = 0; m < 4; ++m) { const size_t row = row0 + ai * 128 + m * 16;
                const float rstd3 = rsqrtf(__hip_atomic_load(rss3 + row, __ATOMIC_RELAXED, __HIP_MEMORY_SCOPE_AGENT) * (1.0f / 1024.0f) + EPS);
#pragma unroll
                for (int bj = 0; bj < 2; ++bj) { const size_t o = row * 1024 + col0 + bj * 128; const int col = col0 + bj * 128;
                    const f32x4 g0 = *(const f32x4*)(gfin + col), g1 = *(const f32x4*)(gfin + col + 4);
                    *(f32x4*)(out + o) = acc[ai][bj][m][0] * rstd3 * g0; *(f32x4*)(out + o + 4) = acc[ai][bj][m][1] * rstd3 * g1; } }
    }
};

DI int win_colmap(int j) { return j < 3584 ? j : (j < 5632 ? j + 16 : (j < 5648 ? j - 2048 : -1)); }
template <int MODE>
DI void tr_item(const float* W, int ldw, int K, bf16_t* WT, int row_off, const float* gain, LAS float* scr, int item, int nblk, int lane) {
    const int kb = item / nblk, nb = item % nblk, k0 = 64 * kb, n0 = 32 * nb;
    const int j = n0 + (lane & 31);
    const int src = MODE == 1 ? win_colmap(j) : j;
    float tv[32];
#pragma unroll
    for (int i = 0; i < 32; ++i) { const int kk = 2 * i + (lane >> 5); tv[i] = W[(size_t)(k0 + kk) * ldw + (src >= 0 ? src : 0)]; }
    if (gain) {
#pragma unroll
        for (int i = 0; i < 32; ++i) tv[i] *= gain[k0 + 2 * i + (lane >> 5)]; }
#pragma unroll
    for (int i = 0; i < 32; ++i) { const int kk = 2 * i + (lane >> 5); scr[kk * 33 + (lane & 31)] = src >= 0 ? tv[i] : 0.f; }
    LDS_WAIT();
    const int c = lane & 7;
#pragma unroll
    for (int jj = 0; jj < 4; ++jj) { const int n = (lane >> 3) + 8 * jj; const LAS float* s = scr + (8 * c) * 33 + n;
        u32x4 o = {pk2(s[0], s[33]), pk2(s[66], s[99]), pk2(s[132], s[165]), pk2(s[198], s[231])};
        *(u32x4*)(WT + (size_t)(row_off + n0 + n) * K + k0 + 8 * c) = o; }
    LDS_WAIT();
}
DI void p0_weights(const Args& a, LAS unsigned char* lds, int it0, int it1, int vc, int nvc) {
    const int tid = otid(a.wv), lane = tid & 63, w = tid >> 6;
    unsigned char* ws = a.ws;
    LAS float* scr = (LAS float*)(lds + w * 8704);
    constexpr int I_IN = 16 * 184, I_A = 8 * 32, I_O = 16 * 32, I_1 = 16 * 128, I_2 = 64 * 32;
    for (int it = it0 + vc * 8 + w; it < it1; it += nvc * 8) {
        int r = it;
        if (r < I_IN) { tr_item<1>(a.in[3], 5648, 1024, (bf16_t*)(ws + OFF_WIN), 0, nullptr, scr, r, 184, lane); continue; } r -= I_IN;
        if (r < I_A) { tr_item<0>(a.in[11], 1024, 512, (bf16_t*)(ws + OFF_WAD), 0, nullptr, scr, r, 32, lane); continue; } r -= I_A;
        if (r < I_A) { tr_item<0>(a.in[12], 1024, 512, (bf16_t*)(ws + OFF_WAD), 1024, nullptr, scr, r, 32, lane); continue; } r -= I_A;
        if (r < I_O) { tr_item<0>(a.in[13], 1024, 1024, (bf16_t*)(ws + OFF_WO), 0, nullptr, scr, r, 32, lane); continue; } r -= I_O;
        if (r < I_1) { tr_item<0>(a.in[15], 4096, 1024, (bf16_t*)(ws + OFF_W1), 0, a.in[14], scr, r, 128, lane); continue; } r -= I_1;
        if (r < I_2) { tr_item<0>(a.in[16], 1024, 4096, (bf16_t*)(ws + OFF_W2), 0, nullptr, scr, r, 32, lane); continue; } r -= I_2;
        if (r < I_O) { tr_item<0>(a.in[18], 1024, 1024, (bf16_t*)(ws + OFF_WPG), 0, a.in[17], scr, r, 32, lane); continue; } r -= I_O;
        tr_item<0>(a.in[19], 1024, 256, (bf16_t*)(ws + OFF_WPP), 0, nullptr, scr, r, 32, lane);
    }
}
constexpr int P0_I_IN = 16 * 184, P0_NIT = 16 * 184 + 2 * 8 * 32 + 16 * 32 + 16 * 128 + 64 * 32 + 16 * 32 + 4 * 32;
DI void phase0(const Args& a, LAS unsigned char* lds) {
    const int tid = otid(a.wv), lane = tid & 63, w = tid >> 6;
    const int gw = blockIdx.x * 8 + w, NGW = gridDim.x * 8;
    unsigned char* ws = a.ws;
    p0_weights(a, lds, 0, gridDim.x == 256 ? P0_I_IN : P0_NIT, blockIdx.x, gridDim.x);
    const float* x = a.in[0]; const float* gm = a.in[2]; bf16_t* xn = (bf16_t*)(ws + A_XN);
    for (int row0 = gw * 2; row0 < MTOK; row0 += NGW * 2) {
        f32x4 v[2][4]; float s[2] = {0.f, 0.f};
#pragma unroll
        for (int r = 0; r < 2; ++r) { const f32x4* xr = (const f32x4*)(x + (size_t)(row0 + r) * 1024) + lane;
#pragma unroll
            for (int j = 0; j < 4; ++j) v[r][j] = xr[64 * j]; }
#pragma unroll
        for (int r = 0; r < 2; ++r)
#pragma unroll
            for (int j = 0; j < 4; ++j) s[r] += (v[r][j][0] * v[r][j][0] + v[r][j][1] * v[r][j][1]) + (v[r][j][2] * v[r][j][2] + v[r][j][3] * v[r][j][3]);
#pragma unroll
        for (int o = 1; o < 64; o <<= 1) { s[0] += __shfl_xor(s[0], o); s[1] += __shfl_xor(s[1], o); }
#pragma unroll
        for (int r = 0; r < 2; ++r) { const float rstd = rsqrtf(s[r] * (1.0f / 1024.0f) + EPS);
            u32x2* o8 = (u32x2*)(xn + (size_t)(row0 + r) * 1024) + lane;
#pragma unroll
            for (int j = 0; j < 4; ++j) { const f32x4 g = *((const f32x4*)gm + lane + 64 * j);
                u32x2 o = {pk2(v[r][j][0] * rstd * g[0], v[r][j][1] * rstd * g[1]), pk2(v[r][j][2] * rstd * g[2], v[r][j][3] * rstd * g[3])}; o8[64 * j] = o; } }
    }
    { float* rss = (float*)(ws + OFF_RSS); for (int i = blockIdx.x * 512 + tid; i < 3 * MTOK; i += gridDim.x * 512) rss[i] = 0.f;
      unsigned* cnt = (unsigned*)(ws + OFF_CNT); for (int i = blockIdx.x * 512 + tid; i < 1024; i += gridDim.x * 512) cnt[i] = 0u;
      unsigned* flg = (unsigned*)(ws + OFF_FLG); for (int i = blockIdx.x * 512 + tid; i < 4096; i += gridDim.x * 512) flg[i] = 0u; }
}

DI float softplusf_(float x) { return fmaxf(x, 0.f) + log1pf(__expf(-fabsf(x))); }
DI float siluf_(float v) { return v * sigmoidf_(v); }
template <int KIND>
DI void p2_head(const Args& a, int b, int s0, int h, int lane) {
    const bf16_t* proja = (const bf16_t*)(a.ws + A_PROJA);
    bf16_t* QT = (bf16_t*)a.out; bf16_t* KT = QT + (size_t)MTOK * 512; bf16_t* VT = KT + (size_t)MTOK * 512; bf16_t* KTT = (bf16_t*)(a.ws + A_KTT);
    const int ch = KIND * 512 + h * 128 + 2 * lane;
    const float* cw = a.in[5];
    const float w00 = cw[ch], w01 = cw[ch + 1], w10 = cw[1536 + ch], w11 = cw[1536 + ch + 1], w20 = cw[3072 + ch], w21 = cw[3072 + ch + 1];
    const unsigned* src = (const unsigned*)(proja + (size_t)b * SEQ * 3072 + 1536 + ch);
    unsigned rw[34];
#pragma unroll
    for (int t = 0; t < 34; ++t) { const int s = s0 - 1 + t; rw[t] = (s >= 0 && s < SEQ) ? src[(size_t)s * 1536] : 0u; }
    float lo[32], hi[32], ss[32];
#pragma unroll
    for (int t = 0; t < 32; ++t) {
        lo[t] = siluf_(bf_lo(rw[t]) * w00 + bf_lo(rw[t + 1]) * w10 + bf_lo(rw[t + 2]) * w20);
        hi[t] = siluf_(bf_hi(rw[t]) * w01 + bf_hi(rw[t + 1]) * w11 + bf_hi(rw[t + 2]) * w21);
        ss[t] = lo[t] * lo[t] + hi[t] * hi[t];
    }
    if (KIND < 2) {
#pragma unroll
        for (int o = 1; o < 64; o <<= 1)
#pragma unroll
            for (int t = 0; t < 32; ++t) ss[t] += __shfl_xor(ss[t], o);
#pragma unroll
        for (int t = 0; t < 32; ++t) { const float rn = rsqrtf(ss[t] + EPS) * (KIND == 0 ? 0.08838834764831845f : 1.0f); lo[t] *= rn; hi[t] *= rn; }
    }
#pragma unroll
    for (int t = 0; t < 32; ++t) {
        const size_t tok = (size_t)b * SEQ + s0 + t;
        if (KIND == 2) { *(unsigned*)(VT + tok * 512 + h * 128 + 2 * lane) = pk2(lo[t], hi[t]); }
        else { const int d = 2 * lane, d32 = d & 31, pos = (d & ~31) + ((d32 >> 2) & 3) * 8 + (d32 >> 4) * 4 + (d32 & 3);
            *(unsigned*)((KIND == 0 ? QT : KT) + tok * 512 + h * 128 + pos) = pk2(lo[t], hi[t]); }
    }
    if (KIND == 1) {
        bf16_t* r0 = KTT + ((size_t)((b * 4 + h) * 128 + 2 * lane) * SEQ + s0);
        bf16_t* r1 = r0 + SEQ;
#pragma unroll
        for (int q4 = 0; q4 < 4; ++q4) { u32x4 o0, o1;
#pragma unroll
            for (int e = 0; e < 4; ++e) { const int p = q4 * 8 + e * 2, t0 = ((p & 7) >> 2) * 16 + (p >> 3) * 4 + (p & 3), t1 = t0 + 1;
                o0[e] = pk2(lo[t0], lo[t1]); o1[e] = pk2(hi[t0], hi[t1]); }
            *(u32x4*)(r0 + q4 * 8) = o0; *(u32x4*)(r1 + q4 * 8) = o1; }
    }
}
DI void p2_mixa(const Args& a, int b, int s0, int blk, int lane) {
    const bf16_t* proja = (const bf16_t*)(a.ws + A_PROJA);
    bf16_t* YA = (bf16_t*)a.out + (size_t)3 * MTOK * 512;
    const int c = blk * 128 + 2 * lane;
    const float* cw = a.in[4];
    const float w00 = cw[c], w01 = cw[c + 1], w10 = cw[512 + c], w11 = cw[512 + c + 1], w20 = cw[1024 + c], w21 = cw[1024 + c + 1];
    const unsigned* src = (const unsigned*)(proja + (size_t)b * SEQ * 3072 + c);
    float p0 = 0.f, p1 = 0.f, c0, c1;
    if (s0 > 0) { const unsigned bb = src[(size_t)(s0 - 1) * 1536], xx = src[(size_t)(s0 - 1) * 1536 + 512]; p0 = bf_lo(bb) * bf_lo(xx); p1 = bf_hi(bb) * bf_hi(xx); }
    { const unsigned bb = src[(size_t)s0 * 1536], xx = src[(size_t)s0 * 1536 + 512]; c0 = bf_lo(bb) * bf_lo(xx); c1 = bf_hi(bb) * bf_hi(xx); }
#pragma unroll 4
    for (int t = 0; t < 32; ++t) {
        const int s = s0 + t; float n0 = 0.f, n1 = 0.f;
        if (s + 1 < SEQ) { const unsigned bb = src[(size_t)(s + 1) * 1536], xx = src[(size_t)(s + 1) * 1536 + 512]; n0 = bf_lo(bb) * bf_lo(xx); n1 = bf_hi(bb) * bf_hi(xx); }
        const unsigned cc = src[(size_t)s * 1536 + 256];
        const float y0 = bf_lo(cc) * (p0 * w00 + c0 * w10 + n0 * w20), y1 = bf_hi(cc) * (p1 * w01 + c1 * w11 + n1 * w21);
        *(unsigned*)(YA + ((size_t)b * SEQ + s) * 512 + c) = pk2(y0, y1);
        p0 = c0; p1 = c1; c0 = n0; c1 = n1;
    }
}
DI void phase2(const Args& a) {
    const int tid = otid(a.wv), lane = tid & 63, w = tid >> 6;
    { const float* sm = (const float*)(a.ws + OFF_SMALL); float* gb = (float*)(a.ws + OFF_GB);
      for (int i = blockIdx.x * 512 + tid; i < MTOK * 4; i += gridDim.x * 512) { const int t = i >> 2, h = i & 3; const float* r = sm + (size_t)t * 16;
          gb[t * 16 + h] = -__expf(a.in[6][h]) * softplusf_(r[8 + h] + a.in[8][h]);
          gb[t * 16 + 4 + h] = -__expf(a.in[7][h]) * softplusf_(r[12 + h] + a.in[9][h]);
          gb[t * 16 + 8 + h] = sigmoidf_(r[h]); gb[t * 16 + 12 + h] = sigmoidf_(r[4 + h]); } }
    const int gw = blockIdx.x * 8 + w, NGW = gridDim.x * 8;
    for (int it = gw; it < 512 * 16; it += NGW) {
        const int grp = it >> 4, sec = ((it & 15) + 4 * (it >> 11)) & 15, b = grp >> 8, s0 = (grp & 255) * 32;
        if (sec < 4) p2_head<0>(a, b, s0, sec, lane);
        else if (sec < 8) p2_head<1>(a, b, s0, sec - 4, lane);
        else if (sec < 12) p2_head<2>(a, b, s0, sec - 8, lane);
        else p2_mixa(a, b, s0, sec - 12, lane);
    }
}

constexpr int L_QS = 0, L_KS = 17408, L_KTS = 34816, L_VTS = 53248, L_AM = 71680, L_TW = 104448, L_TU = 122880, L_GS = 141312;
typedef short s16x4 __attribute__((ext_vector_type(4)));
DI unsigned p3_offb(unsigned row, unsigned ch) { return 256u * row + 16u * (ch ^ (((row & 3u) << 2) | ((row >> 2) & 3u))); }
DI bf16x8 p3_tr_frag(LAS unsigned char* img, int lane, int c, int ks) {
    const unsigned g = (unsigned)lane >> 4, q = ((unsigned)lane & 15u) >> 2, p = (unsigned)lane & 3u;
    const s16x4 r0 = __builtin_amdgcn_ds_read_tr16_b64_v4i16((LAS s16x4*)(img + p3_offb(32u * ks + 8u * g + q, 2u * c + (p >> 1)) + 8u * (p & 1u)));
    const s16x4 r1 = __builtin_amdgcn_ds_read_tr16_b64_v4i16((LAS s16x4*)(img + p3_offb(32u * ks + 8u * g + 4u + q, 2u * c + (p >> 1)) + 8u * (p & 1u)));
    return __builtin_shufflevector(r0, r1, 0, 1, 2, 3, 4, 5, 6, 7);
}
DI void phase3(const Args& a, LAS unsigned char* lds) {
    const bf16_t* QT = (const bf16_t*)a.out; const bf16_t* KT = QT + (size_t)MTOK * 512; const bf16_t* VT = KT + (size_t)MTOK * 512;
    const float* GB = (const float*)(a.ws + OFF_GB);
    unsigned char* OPS = a.ws + A_OPS;
    for (int task = blockIdx.x; task < 1024; task += gridDim.x) {
        const int tid = otid(a.wv), lane = tid & 63, w = tid >> 6, dir = w >> 2, wq = w & 3, m16 = lane & 15, kg = lane >> 4;
        const int bh = task >> 7, nc = task & 127, b = bh >> 2, h = bh & 3;
        const size_t tb = (size_t)b * SEQ + nc * 64;
#pragma unroll
        for (int e = 0; e < 2; ++e) {
            const int ch = tid + 512 * e, row = ch >> 4, c16 = ch & 15;
            const size_t g = (tb + row) * 512 + h * 128 + c16 * 8;
            const u32x4 q = *(const u32x4*)(QT + g); *(LAS u32x4*)(lds + L_QS + row * 272 + c16 * 16) = q;
            const u32x4 k = *(const u32x4*)(KT + g); *(LAS u32x4*)(lds + L_KS + row * 272 + c16 * 16) = k;
            const u32x4 v = *(const u32x4*)(VT + g);
            const int grp = c16 >> 2, kgs = c16 & 3;
            *(LAS u32x4*)(lds + L_VTS + p3_offb(row, c16)) = v;
            { u32x2 k0 = {k[0], k[1]}, k1 = {k[2], k[3]};
              *(LAS u32x2*)(lds + L_KTS + p3_offb(row, grp * 4 + (kgs >> 1)) + 8 * (kgs & 1)) = k0;
              *(LAS u32x2*)(lds + L_KTS + p3_offb(row, grp * 4 + 2 + (kgs >> 1)) + 8 * (kgs & 1)) = k1; }
        }
        if (w < 2) {
            const size_t tok = tb + (w ? 63 - lane : lane);
            float g = GB[tok * 16 + w * 4 + h]; const float bt = GB[tok * 16 + 8 + w * 4 + h];
#pragma unroll
            for (int o = 1; o < 64; o <<= 1) { const float t = __shfl_up(g, o); if (lane >= o) g += t; }
            LAS float* gs = (LAS float*)(lds + L_GS + w * 512);
            gs[lane] = g; gs[64 + lane] = bt;
        }
        __syncthreads();
        const LAS float* Gc = (const LAS float*)(lds + L_GS + dir * 512); const LAS float* Bt = Gc + 64;
        unsigned char* ops = OPS + (size_t)(task * 2 + dir) * OPS_TASK;
        {
            const int prow = dir ? 63 - (wq * 16 + m16) : wq * 16 + m16;
            bf16x8 Af[4], Qf[4];
#pragma unroll
            for (int kk = 0; kk < 4; ++kk) { Af[kk] = *(const LAS bf16x8*)(lds + L_KS + prow * 272 + (kk * 32 + kg * 8) * 2); Qf[kk] = *(const LAS bf16x8*)(lds + L_QS + prow * 272 + (kk * 32 + kg * 8) * 2); }
            LAS float* AM = (LAS float*)(lds + L_AM + dir * 16384);
            f32x4 tl[4];
#pragma unroll
            for (int t = 0; t < 4; ++t) {
                tl[t] = (f32x4){0.f, 0.f, 0.f, 0.f};
                if (t <= wq) {
                    const int trow = dir ? 63 - (t * 16 + m16) : t * 16 + m16;
                    bf16x8 Kf[4];
#pragma unroll
                    for (int kk = 0; kk < 4; ++kk) Kf[kk] = *(const LAS bf16x8*)(lds + L_KS + trow * 272 + (kk * 32 + kg * 8) * 2);
                    f32x4 akk = {0.f, 0.f, 0.f, 0.f}, akq = {0.f, 0.f, 0.f, 0.f};
#pragma unroll
                    for (int kk = 0; kk < 4; ++kk) { akk = MFMA16(Af[kk], Kf[kk], akk); akq = MFMA16(Kf[kk], Qf[kk], akq); }
                    const int jc = t * 16 + m16; const float gj = Gc[jc];
                    const int cq = wq * 16 + m16; const float gcq = Gc[cq];
#pragma unroll
                    for (int r = 0; r < 4; ++r) {
                        const int c = wq * 16 + kg * 4 + r;
                        AM[c * 64 + jc] = (c > jc) ? Bt[c] * akk[r] * __expf(fminf(Gc[c] - gj, 0.f)) : 0.f;
                        const int jj = t * 16 + kg * 4 + r;
                        tl[t][r] = (cq >= jj) ? akq[r] * __expf(fminf(gcq - Gc[jj], 0.f)) : 0.f;
                    }
                }
            }
#pragma unroll
            for (int kk = 0; kk < 2; ++kk) *(bf16x8*)(ops + 16384 + (wq * 2 + kk) * 1024 + lane * 16) = pack8(tl[2 * kk], tl[2 * kk + 1]);
        }
        __syncthreads();
        if (wq == 0) {
            const LAS float* AM = (const LAS float*)(lds + L_AM + dir * 16384);
            typedef float f32x64 __attribute__((ext_vector_type(64))); f32x64 x;
            int lane_o = lane; asm volatile("" : "+v"(lane_o));
            f32x4 av[16], an[8];
#pragma unroll
            for (int q = 0; q < 16; ++q) av[q] = (f32x4){0.f, 0.f, 0.f, 0.f};
#pragma unroll
            for (int q = 0; q < 8; ++q) an[q] = (f32x4){0.f, 0.f, 0.f, 0.f};
            av[0] = *(const LAS f32x4*)(AM + 64);
            x[0] = (lane_o == 0) ? 1.f : 0.f;
#pragma unroll
            for (int i = 1; i < 64; ++i) {
#pragma unroll
                for (int j4 = 8; j4 < (i + 3) / 4; ++j4) av[j4] = *(const LAS f32x4*)(AM + i * 64 + j4 * 4);
                if (i + 1 < 64) {
#pragma unroll
                    for (int j4 = 0; j4 < ((i + 4) / 4 < 8 ? (i + 4) / 4 : 8); ++j4) an[j4] = *(const LAS f32x4*)(AM + (i + 1) * 64 + j4 * 4);
                }
                float s0 = 0.f, s1 = 0.f;
#pragma unroll
                for (int j4 = 0; j4 < (i + 3) / 4; ++j4) {
                    if (j4 * 4 + 0 < i) s0 = fmaf(av[j4][0], x[j4 * 4 + 0], s0);
                    if (j4 * 4 + 1 < i) s1 = fmaf(av[j4][1], x[j4 * 4 + 1], s1);
                    if (j4 * 4 + 2 < i) s0 = fmaf(av[j4][2], x[j4 * 4 + 2], s0);
                    if (j4 * 4 + 3 < i) s1 = fmaf(av[j4][3], x[j4 * 4 + 3], s1);
                }
                float xi = ((lane_o == i) ? 1.f : 0.f) - (s0 + s1);
                asm volatile("" : "+v"(xi) :: "memory");
                x[i] = xi;
#pragma unroll
                for (int j4 = 0; j4 < 8; ++j4) av[j4] = an[j4];
            }
            const float bt = Bt[lane], fu = bt, fw = bt * __expf(Gc[lane]);
            const int cs = dir ? 63 - lane : lane;
            LAS unsigned short* tw = (LAS unsigned short*)(lds + L_TW + dir * 9216 + cs * 2);
            LAS unsigned short* tu = (LAS unsigned short*)(lds + L_TU + dir * 9216 + cs * 2);
#pragma unroll
            for (int i = 0; i < 64; ++i) { const unsigned pw = pk2(x[i] * fw, x[i] * fu); tw[i * 72] = (unsigned short)pw; tu[i * 72] = (unsigned short)(pw >> 16); }
        }
        __syncthreads();
        {
            bf16x8 KA[2][2], VB[2][2];
#pragma unroll
            for (int tt = 0; tt < 2; ++tt)
#pragma unroll
                for (int kk = 0; kk < 2; ++kk) {
                    KA[tt][kk] = p3_tr_frag(lds + L_KTS, lane, 2 * wq + tt, kk);
                    VB[tt][kk] = p3_tr_frag(lds + L_VTS, lane, 2 * wq + tt, kk);
                }
#pragma unroll
            for (int i = 0; i < 4; ++i) {
                bf16x8 TB[2], TA[2];
#pragma unroll
                for (int kk = 0; kk < 2; ++kk) {
                    TB[kk] = *(const LAS bf16x8*)(lds + L_TW + dir * 9216 + (i * 16 + m16) * 144 + (kk * 32 + kg * 8) * 2);
                    TA[kk] = *(const LAS bf16x8*)(lds + L_TU + dir * 9216 + (i * 16 + m16) * 144 + (kk * 32 + kg * 8) * 2);
                }
                f32x4 a0 = {0.f, 0.f, 0.f, 0.f}, a1 = a0, u0 = a0, u1 = a0;
#pragma unroll
                for (int kk = 0; kk < 2; ++kk) { a0 = MFMA16(KA[0][kk], TB[kk], a0); a1 = MFMA16(KA[1][kk], TB[kk], a1); u0 = MFMA16(TA[kk], VB[0][kk], u0); u1 = MFMA16(TA[kk], VB[1][kk], u1); }
                *(bf16x8*)(ops + (i * 4 + wq) * 1024 + lane * 16) = pack8(a0, a1);
                *(f32x4*)(ops + 24576 + ((2 * wq) * 4 + i) * 1024 + lane * 16) = u0;
                *(f32x4*)(ops + 24576 + ((2 * wq + 1) * 4 + i) * 1024 + lane * 16) = u1;
            }
            if (wq == 1) {
                float* sc = (float*)(ops + 57344);
                const float gl = Gc[63], gc = Gc[lane];
                sc[lane] = __expf(gc); sc[64 + lane] = __expf(gl - gc);
                if (lane == 0) sc[128] = __expf(gl);
            }
        }
        __syncthreads();
    }
}

constexpr int SB_BYTES = 62464;
constexpr int X_OFF = 2 * SB_BYTES;
DI void scan_task(const Args& a, LAS unsigned char* lds, int bh, int dir, int dvt) {
    const int tid = otid(a.wv), lane = tid & 63, w = __builtin_amdgcn_readfirstlane(tid >> 6), m16 = lane & 15, kg = lane >> 4;
    const int b = bh >> 2, h = bh & 3;
    if (w < 4) {
        const int j = w;
        bf16_t* OD = (bf16_t*)a.out + (size_t)MTOK * 512 * (1 + dir);
        f32x4 S0 = {0.f, 0.f, 0.f, 0.f}, S1 = S0;
        LAS unsigned char* XL = lds + X_OFF + lane * 16;
        *(LAS bf16x8*)(XL + j * 1024) = pack8(S0, S1);
        for (int n = 0; n < 128; ++n) {
            LDS_WAIT(); __builtin_amdgcn_s_barrier(); asm volatile("" ::: "memory");
            const LAS unsigned char* B = lds + (n & 1) * SB_BYTES;
            const LAS unsigned char* BL = B + lane * 16;
            bf16x8 Sb[4];
#pragma unroll
            for (int kk = 0; kk < 4; ++kk) Sb[kk] = *(const LAS bf16x8*)(XL + kk * 1024);
            const f32x4 eg = *(const LAS f32x4*)(B + 28672 + (j * 16 + kg * 4) * 4), el = *(const LAS f32x4*)(B + 28672 + 256 + (j * 16 + kg * 4) * 4);
            const float egl = *(const LAS float*)(B + 28672 + 512);
            f32x4 acc = {0.f, 0.f, 0.f, 0.f}, o = acc;
#pragma unroll
            for (int kk = 0; kk < 4; ++kk) { acc = MFMA16(*(const LAS bf16x8*)(BL + (j * 4 + kk) * 1024), Sb[kk], acc); o = MFMA16(*(const LAS bf16x8*)(BL + 29696 + (j * 4 + kk) * 1024), Sb[kk], o); }
            const f32x4 vn = *(const LAS f32x4*)(BL + 24576 + j * 1024) - acc;
            const f32x4 vs = vn * el;
            { u32x2 vb = {pk2(vn[0], vn[1]), pk2(vn[2], vn[3])};
              *(LAS u32x2*)(XL + 6144 + (j >> 1) * 1024 + (j & 1) * 8) = vb;
              u32x2 vd; int off;
              if (!dir) { vd = (u32x2){pk2(vs[0], vs[1]), pk2(vs[2], vs[3])}; off = (j & 1) * 8; }
              else { vd = (u32x2){pk2(vs[3], vs[2]), pk2(vs[1], vs[0])}; off = (1 - (j & 1)) * 8; }
              *(LAS u32x2*)(XL + 4096 + (j >> 1) * 1024 + off) = vd; }
            o = o * eg;
            LDS_WAIT(); __builtin_amdgcn_s_barrier(); asm volatile("" ::: "memory");
            const bf16x8 Vd0 = *(const LAS bf16x8*)(XL + 4096), Vd1 = *(const LAS bf16x8*)(XL + 5120), Vb0 = *(const LAS bf16x8*)(XL + 6144), Vb1 = *(const LAS bf16x8*)(XL + 7168);
            S0 = S0 * egl; S1 = S1 * egl;
            S0 = MFMA16(*(const LAS bf16x8*)(BL + 46080 + (4 * j) * 1024), Vd0, S0); S1 = MFMA16(*(const LAS bf16x8*)(BL + 46080 + (4 * j + 2) * 1024), Vd0, S1);
            S0 = MFMA16(*(const LAS bf16x8*)(BL + 46080 + (4 * j + 1) * 1024), Vd1, S0); S1 = MFMA16(*(const LAS bf16x8*)(BL + 46080 + (4 * j + 3) * 1024), Vd1, S1);
            o = MFMA16(*(const LAS bf16x8*)(BL + 16384 + (2 * j) * 1024), Vb0, o);
            o = MFMA16(*(const LAS bf16x8*)(BL + 16384 + (2 * j + 1) * 1024), Vb1, o);
            *(LAS bf16x8*)(XL + j * 1024) = pack8(S0, S1);
            const int nc = dir ? 127 - n : n;
            const size_t tokb = (size_t)b * SEQ + nc * 64;
#pragma unroll
            for (int r = 0; r < 4; ++r) { const int c = j * 16 + kg * 4 + r; const size_t tok = tokb + (dir ? 63 - c : c);
                OD[tok * 512 + h * 128 + dvt * 16 + m16] = (bf16_t)pk2(o[r], 0.f); }
        }
    } else {
        const int li = w - 4;
        const unsigned char* OPS = a.ws + A_OPS; const bf16_t* QT = (const bf16_t*)a.out; const bf16_t* KTT = (const bf16_t*)(a.ws + A_KTT);
        const int nc0 = dir ? 127 : 0;
        const unsigned char* ops0 = OPS + (size_t)((bh * 128 + nc0) * 2 + dir) * OPS_TASK;
        const long st_ops = dir ? -2L * OPS_TASK : 2L * OPS_TASK, st_q = dir ? -65536L : 65536L, st_k = dir ? -128L : 128L;
        const unsigned char* ptr[16]; long stride[16]; unsigned ldso[16];
#pragma unroll
        for (int k = 0; k < 16; ++k) {
            const int u = min(li + 4 * k, 60); ldso[k] = (unsigned)(u * 1024 + lane * 16);
            const unsigned char* p = ops0; long st = st_ops;
            if (u < 24) p = ops0 + u * 1024 + lane * 16;
            else if (u < 28) p = ops0 + 24576 + (dvt * 4 + (u - 24)) * 1024 + lane * 16;
            else if (u == 28) p = ops0 + 57344 + lane * 16;
            else if (u < 45) { const int f = u - 29, i = f >> 2, kk = f & 3, c = i * 16 + m16; const size_t tok = (size_t)b * SEQ + nc0 * 64 + (dir ? 63 - c : c);
                p = (const unsigned char*)(QT + tok * 512 + h * 128 + kk * 32 + kg * 8); st = st_q; }
            else { const int f = u - 45, t = f >> 1, kk = f & 1, dk = t * 16 + m16; const int pos = nc0 * 64 + (dir ? (1 - kk) * 32 + (3 - kg) * 8 : kk * 32 + kg * 8);
                p = (const unsigned char*)(KTT + ((size_t)(bh * 128 + dk) * SEQ + pos)); st = st_k; }
            ptr[k] = p; stride[k] = st;
        }
        u32x4 R0[16], R1[16];
#pragma unroll
        for (int k = 0; k < 16; ++k) { R0[k] = *(GAS const u32x4*)ptr[k]; ptr[k] += stride[k]; }
#pragma unroll
        for (int k = 0; k < 16; ++k) { R1[k] = *(GAS const u32x4*)ptr[k]; ptr[k] += stride[k]; }
        for (int n = 0; n < 128; n += 2) {
            const long adv0 = (n + 3 < 128) ? 1L : 0L, adv1 = (n + 4 < 128) ? 1L : 0L;
#pragma unroll
            for (int k = 0; k < 16; ++k) *(LAS u32x4*)(lds + ldso[k]) = R0[k];
#pragma unroll
            for (int k = 0; k < 16; ++k) { R0[k] = *(GAS const u32x4*)ptr[k]; ptr[k] += stride[k] * adv0; }
            LDS_WAIT(); __builtin_amdgcn_s_barrier(); __builtin_amdgcn_s_barrier();
#pragma unroll
            for (int k = 0; k < 16; ++k) *(LAS u32x4*)(lds + SB_BYTES + ldso[k]) = R1[k];
#pragma unroll
            for (int k = 0; k < 16; ++k) { R1[k] = *(GAS const u32x4*)ptr[k]; ptr[k] += stride[k] * adv1; }
            LDS_WAIT(); __builtin_amdgcn_s_barrier(); __builtin_amdgcn_s_barrier();
        }
    }
    __syncthreads();
}

typedef GAS unsigned long long gu64; typedef GAS unsigned gu32;
#define RLX_AGENT __ATOMIC_RELAXED, __HIP_MEMORY_SCOPE_AGENT
DI void spin_ge(gu32* word, unsigned want, unsigned& seen) {
    if (seen >= want) return;
    unsigned sp = 0, v;
    while ((v = (unsigned)__builtin_amdgcn_readfirstlane(__hip_atomic_load(word, RLX_AGENT))) < want) { __builtin_amdgcn_s_sleep(1); if (++sp > (1u << 22)) break; }
    seen = v;
    asm volatile("" ::: "memory");
}
constexpr int SCAN_NT = 1;
template <int NT>
DI void scan_A(const Args& a, LAS unsigned char* lds, int t, int bh, int dir, int dvt0) {
    constexpr int SA = 16384 + NT * 4096 + 1024 + 16384, O_U = 16384, O_SC = 16384 + NT * 4096, O_KF = O_SC + 1024, NU = 33 + 4 * NT, NK = (NU + 2) / 3;
    constexpr int XA = 2 * SA, X_VD = NT * 4096, X_VB = NT * 4096 + NT * 2048;
    const int tid = otid(a.wv), lane = tid & 63, w = __builtin_amdgcn_readfirstlane(tid >> 6), m16 = lane & 15, kg = lane >> 4;
    LAS unsigned char* XL = lds + XA + lane * 16;
    if (w < 4) {
        const int j = w;
        f32x4 S0[NT], S1[NT];
#pragma unroll
        for (int e = 0; e < NT; ++e) { S0[e] = (f32x4){0.f, 0.f, 0.f, 0.f}; S1[e] = S0[e]; *(LAS bf16x8*)(XL + e * 4096 + j * 1024) = pack8(S0[e], S1[e]); }
        for (int n = 0; n < 128; ++n) {
            LDS_WAIT(); __builtin_amdgcn_s_barrier(); asm volatile("" ::: "memory");
            const LAS unsigned char* B = lds + (n & 1) * SA;
            const LAS unsigned char* BL = B + lane * 16;
            const f32x4 el = *(const LAS f32x4*)(B + O_SC + 256 + (j * 16 + kg * 4) * 4);
            const float egl = *(const LAS float*)(B + O_SC + 512);
            bf16x8 Wf[4];
#pragma unroll
            for (int kk = 0; kk < 4; ++kk) Wf[kk] = *(const LAS bf16x8*)(BL + (j * 4 + kk) * 1024);
#pragma unroll
            for (int e = 0; e < NT; ++e) {
                f32x4 acc = {0.f, 0.f, 0.f, 0.f};
#pragma unroll
                for (int kk = 0; kk < 4; ++kk) acc = MFMA16(Wf[kk], *(const LAS bf16x8*)(XL + e * 4096 + kk * 1024), acc);
                const f32x4 vn = *(const LAS f32x4*)(BL + O_U + e * 4096 + j * 1024) - acc;
                const f32x4 vs = vn * el;
                u32x2 vb = {pk2(vn[0], vn[1]), pk2(vn[2], vn[3])};
                *(LAS u32x2*)(XL + X_VB + e * 2048 + (j >> 1) * 1024 + (j & 1) * 8) = vb;
                u32x2 vd; int off;
                if (!dir) { vd = (u32x2){pk2(vs[0], vs[1]), pk2(vs[2], vs[3])}; off = (j & 1) * 8; }
                else { vd = (u32x2){pk2(vs[3], vs[2]), pk2(vs[1], vs[0])}; off = (1 - (j & 1)) * 8; }
                *(LAS u32x2*)(XL + X_VD + e * 2048 + (j >> 1) * 1024 + off) = vd;
            }
            LDS_WAIT(); __builtin_amdgcn_s_barrier(); asm volatile("" ::: "memory");
            bf16x8 Kf[4];
#pragma unroll
            for (int q = 0; q < 4; ++q) Kf[q] = *(const LAS bf16x8*)(BL + O_KF + (4 * j + q) * 1024);
#pragma unroll
            for (int e = 0; e < NT; ++e) {
                const bf16x8 Vd0 = *(const LAS bf16x8*)(XL + X_VD + e * 2048), Vd1 = *(const LAS bf16x8*)(XL + X_VD + e * 2048 + 1024);
                f32x4 s0 = S0[e] * egl, s1 = S1[e] * egl;
                s0 = MFMA16(Kf[0], Vd0, s0); s1 = MFMA16(Kf[2], Vd0, s1);
                s0 = MFMA16(Kf[1], Vd1, s0); s1 = MFMA16(Kf[3], Vd1, s1);
                S0[e] = s0; S1[e] = s1;
                *(LAS bf16x8*)(XL + e * 4096 + j * 1024) = pack8(s0, s1);
            }
        }
    } else if (w < 7) {
        const int li = w - 4;
        const unsigned char* OPS = a.ws + A_OPS; const bf16_t* KTT = (const bf16_t*)(a.ws + A_KTT);
        const int nc0 = dir ? 127 : 0;
        const unsigned char* ops0 = OPS + (size_t)((bh * 128 + nc0) * 2 + dir) * OPS_TASK;
        const long st_ops = dir ? -2L * OPS_TASK : 2L * OPS_TASK, st_k = dir ? -128L : 128L;
        const unsigned char* ptr[NK]; long stride[NK]; unsigned ldso[NK];
#pragma unroll
        for (int k = 0; k < NK; ++k) {
            const int u = min(li + 3 * k, NU - 1); ldso[k] = (unsigned)(u * 1024 + lane * 16);
            const unsigned char* p = ops0; long st = st_ops;
            if (u < 16) p = ops0 + u * 1024 + lane * 16;
            else if (u < 16 + 4 * NT) p = ops0 + 24576 + (dvt0 * 4 + (u - 16)) * 1024 + lane * 16;
            else if (u == 16 + 4 * NT) p = ops0 + 57344 + lane * 16;
            else { const int f = u - (17 + 4 * NT), tt = f >> 1, kk = f & 1, dk = tt * 16 + m16; const int pos = nc0 * 64 + (dir ? (1 - kk) * 32 + (3 - kg) * 8 : kk * 32 + kg * 8);
                p = (const unsigned char*)(KTT + ((size_t)(bh * 128 + dk) * SEQ + pos)); st = st_k; }
            ptr[k] = p; stride[k] = st;
        }
        constexpr int DA = 3;
        u32x4 R[DA][NK];
#pragma unroll
        for (int d = 0; d < DA; ++d)
#pragma unroll
            for (int k = 0; k < NK; ++k) { R[d][k] = *(GAS const u32x4*)ptr[k]; ptr[k] += stride[k]; }
        int n = 0;
        for (; n + DA <= 128; n += DA) {
#pragma unroll
            for (int sidx = 0; sidx < DA; ++sidx) {
                const int m = n + sidx; const unsigned bo = (m & 1) ? (unsigned)SA : 0u; const long adv = (m + DA + 1 < 128) ? 1L : 0L;
#pragma unroll
                for (int k = 0; k < NK; ++k) *(LAS u32x4*)(lds + bo + ldso[k]) = R[sidx][k];
#pragma unroll
                for (int k = 0; k < NK; ++k) { R[sidx][k] = *(GAS const u32x4*)ptr[k]; ptr[k] += stride[k] * adv; }
                LDS_WAIT(); __builtin_amdgcn_s_barrier(); __builtin_amdgcn_s_barrier();
            }
        }
#pragma unroll
        for (int sidx = 0; sidx < 128 % DA; ++sidx) {
            const int m = n + sidx; const unsigned bo = (m & 1) ? (unsigned)SA : 0u;
#pragma unroll
            for (int k = 0; k < NK; ++k) *(LAS u32x4*)(lds + bo + ldso[k]) = R[sidx][k];
            LDS_WAIT(); __builtin_amdgcn_s_barrier(); __builtin_amdgcn_s_barrier();
        }
    } else {
        gu32* prod = (gu32*)(a.ws + OFF_FLG) + 16 * t; gu32* ack = (gu32*)(a.ws + OFF_FLG + 8192) + 16 * t;
        unsigned char* ring = a.ws + OFF_RING + (size_t)t * RING_R * (RING_SLOT * NT);
        const __amdgpu_buffer_rsrc_t rrs = __builtin_amdgcn_make_buffer_rsrc(ring, 0, RING_R * RING_SLOT * NT, 0x00020000);
        unsigned ack_seen = 0u;
        for (int n = 0; n < 128; ++n) {
            __builtin_amdgcn_s_barrier(); asm volatile("" ::: "memory");
            u32x4 pv[6 * NT];
#pragma unroll
            for (int e = 0; e < NT; ++e)
#pragma unroll
                for (int kk = 0; kk < 4; ++kk) pv[e * 6 + kk] = *(const LAS u32x4*)(XL + e * 4096 + kk * 1024);
            LDS_WAIT(); __builtin_amdgcn_s_barrier(); asm volatile("" ::: "memory");
#pragma unroll
            for (int e = 0; e < NT; ++e) { pv[e * 6 + 4] = *(const LAS u32x4*)(XL + X_VB + e * 2048); pv[e * 6 + 5] = *(const LAS u32x4*)(XL + X_VB + e * 2048 + 1024); }
            LDS_WAIT();
            if (n >= 2) { if (NT == 1) asm volatile("s_waitcnt vmcnt(6)" ::: "memory"); else asm volatile("s_waitcnt vmcnt(12)" ::: "memory");
                if (lane == 0) __hip_atomic_store(prod, (unsigned)(n - 1), RLX_AGENT); }
            if (n >= RING_R) spin_ge(ack, (unsigned)(n - RING_R + 1), ack_seen);
            const unsigned so = (unsigned)(n % RING_R) * (unsigned)(RING_SLOT * NT) + (unsigned)lane * 16u;
#pragma unroll
            for (int f = 0; f < 6 * NT; ++f) __builtin_amdgcn_raw_buffer_store_b128(pv[f], rrs, so + f * 1024, 0, 16);
        }
        asm volatile("s_waitcnt vmcnt(0)" ::: "memory"); if (lane == 0) __hip_atomic_store(prod, 128u, RLX_AGENT);
    }
    __syncthreads();
}
template <int NT>
DI void scan_B(const Args& a, LAS unsigned char* lds, int t, int bh, int dir, int dvt0) {
    constexpr int SBB = 25600 + NT * 6144, NF = 6 * NT;
    const int tid = otid(a.wv), lane = tid & 63, w = __builtin_amdgcn_readfirstlane(tid >> 6), m16 = lane & 15, kg = lane >> 4;
    const int b = bh >> 2, h = bh & 3;
    if (w < 4) {
        const int j = w;
        bf16_t* OD = (bf16_t*)a.out + (size_t)MTOK * 512 * (1 + dir);
        for (int n = 0; n < 128; ++n) {
            __builtin_amdgcn_s_barrier(); asm volatile("" ::: "memory");
            const LAS unsigned char* B = lds + (n & 1) * SBB;
            const LAS unsigned char* BL = B + lane * 16;
            const f32x4 eg = *(const LAS f32x4*)(B + 24576 + (j * 16 + kg * 4) * 4);
            bf16x8 Qf[4], If[2];
#pragma unroll
            for (int kk = 0; kk < 4; ++kk) Qf[kk] = *(const LAS bf16x8*)(BL + (j * 4 + kk) * 1024);
            If[0] = *(const LAS bf16x8*)(BL + 16384 + (2 * j) * 1024); If[1] = *(const LAS bf16x8*)(BL + 16384 + (2 * j + 1) * 1024);
            const int nc = dir ? 127 - n : n;
            const size_t tokb = (size_t)b * SEQ + nc * 64;
#pragma unroll
            for (int e = 0; e < NT; ++e) {
                f32x4 o = {0.f, 0.f, 0.f, 0.f};
#pragma unroll
                for (int kk = 0; kk < 4; ++kk) o = MFMA16(Qf[kk], *(const LAS bf16x8*)(BL + 25600 + (e * 6 + kk) * 1024), o);
                o = o * eg;
                o = MFMA16(If[0], *(const LAS bf16x8*)(BL + 25600 + (e * 6 + 4) * 1024), o);
                o = MFMA16(If[1], *(const LAS bf16x8*)(BL + 25600 + (e * 6 + 5) * 1024), o);
#pragma unroll
                for (int r = 0; r < 4; ++r) { const int c = j * 16 + kg * 4 + r; const size_t tok = tokb + (dir ? 63 - c : c);
                    OD[tok * 512 + h * 128 + (dvt0 + e) * 16 + m16] = (bf16_t)pk2(o[r], 0.f); }
            }
            LDS_WAIT();
        }
    } else if (w < 7) {
        const int li = w - 4;
        const unsigned char* OPS = a.ws + A_OPS; const bf16_t* QT = (const bf16_t*)a.out;
        const int nc0 = dir ? 127 : 0;
        const unsigned char* ops0 = OPS + (size_t)((bh * 128 + nc0) * 2 + dir) * OPS_TASK;
        const long st_ops = dir ? -2L * OPS_TASK : 2L * OPS_TASK, st_q = dir ? -65536L : 65536L;
        const unsigned char* ptr[9]; long stride[9]; unsigned ldso[9];
#pragma unroll
        for (int k = 0; k < 9; ++k) {
            const int u = min(li + 3 * k, 24); ldso[k] = (unsigned)(u * 1024 + lane * 16);
            const unsigned char* p = ops0; long st = st_ops;
            if (u < 16) { const int i = u >> 2, kk = u & 3, c = i * 16 + m16; const size_t tok = (size_t)b * SEQ + nc0 * 64 + (dir ? 63 - c : c);
                p = (const unsigned char*)(QT + tok * 512 + h * 128 + kk * 32 + kg * 8); st = st_q; }
            else if (u < 24) p = ops0 + 16384 + (u - 16) * 1024 + lane * 16;
            else p = ops0 + 57344 + lane * 16;
            ptr[k] = p; stride[k] = st;
        }
        constexpr int DB = 4;
        u32x4 R[DB][9];
#pragma unroll
        for (int d = 0; d < DB; ++d)
#pragma unroll
            for (int k = 0; k < 9; ++k) { R[d][k] = *(GAS const u32x4*)ptr[k]; ptr[k] += stride[k]; }
        for (int n = 0; n < 128; n += DB) {
#pragma unroll
            for (int sidx = 0; sidx < DB; ++sidx) {
                const int m = n + sidx; const unsigned bo = (m & 1) ? (unsigned)SBB : 0u; const long adv = (m + DB + 1 < 128) ? 1L : 0L;
#pragma unroll
                for (int k = 0; k < 9; ++k) *(LAS u32x4*)(lds + bo + ldso[k]) = R[sidx][k];
#pragma unroll
                for (int k = 0; k < 9; ++k) { R[sidx][k] = *(GAS const u32x4*)ptr[k]; ptr[k] += stride[k] * adv; }
                LDS_WAIT(); __builtin_amdgcn_s_barrier();
            }
        }
    } else {
        gu32* prod = (gu32*)(a.ws + OFF_FLG) + 16 * t; gu32* ack = (gu32*)(a.ws + OFF_FLG + 8192) + 16 * t;
        const unsigned char* ring = a.ws + OFF_RING + (size_t)t * RING_R * (RING_SLOT * NT);
        constexpr int DC = 2;
        const __amdgpu_buffer_rsrc_t rrs = __builtin_amdgcn_make_buffer_rsrc((unsigned char*)ring, 0, RING_R * RING_SLOT * NT, 0x00020000);
        u32x4 P[DC][NF];
        unsigned prod_seen = 0u;
#pragma unroll
        for (int d = 0; d < DC; ++d) { spin_ge(prod, (unsigned)(d + 1), prod_seen);
#pragma unroll
            for (int f = 0; f < NF; ++f) P[d][f] = __builtin_amdgcn_raw_buffer_load_b128(rrs, (unsigned)d * (unsigned)(RING_SLOT * NT) + f * 1024 + (unsigned)lane * 16u, 0, 16); }
        for (int n = 0; n < 128; n += DC) {
#pragma unroll
            for (int sidx = 0; sidx < DC; ++sidx) {
                const int m = n + sidx; const unsigned bo = (m & 1) ? (unsigned)SBB : 0u;
#pragma unroll
                for (int f = 0; f < NF; ++f) *(LAS u32x4*)(lds + bo + 25600 + f * 1024 + lane * 16) = P[sidx][f];
                if (lane == 0) __hip_atomic_store(ack, (unsigned)(m + 1), RLX_AGENT);
                if (m + DC < 128) { spin_ge(prod, (unsigned)(m + DC + 1), prod_seen);
                    const unsigned so = (unsigned)((m + DC) % RING_R) * (unsigned)(RING_SLOT * NT) + (unsigned)lane * 16u;
#pragma unroll
                    for (int f = 0; f < NF; ++f) P[sidx][f] = __builtin_amdgcn_raw_buffer_load_b128(rrs, so + f * 1024, 0, 16); }
                LDS_WAIT(); __builtin_amdgcn_s_barrier();
            }
        }
    }
    __syncthreads();
}
DI void phase4(const Args& a, LAS unsigned char* lds) {
    if (gridDim.x == 256) {
        constexpr int TPX = 16 / SCAN_NT;
        const int x = blockIdx.x & 7, sl = blockIdx.x >> 3;
        if (sl < 2 * TPX) {
            const int t = x * TPX + (sl % TPX), grp = t / (8 / SCAN_NT), dvt0 = (t % (8 / SCAN_NT)) * SCAN_NT;
            if (sl < TPX) scan_A<SCAN_NT>(a, lds, t, grp >> 1, grp & 1, dvt0); else scan_B<SCAN_NT>(a, lds, t, grp >> 1, grp & 1, dvt0);
        }
        return;
    }
    for (int t = 0; t < 128; ++t) {
        const int owner = ((t >> 4) + 8 * (t & 15)) % (int)gridDim.x;
        if (owner != (int)blockIdx.x) continue;
        const int grp = t >> 3;
        scan_task(a, lds, grp >> 1, grp & 1, t & 7);
    }
}

DI void phase5(const Args& a) {
    const int tid = otid(a.wv), lane = tid & 63, w = tid >> 6;
    { const f32x4* p4 = (const f32x4*)a.in[1]; u32x2* pb = (u32x2*)(a.ws + OFF_PB);
      for (size_t i = (size_t)blockIdx.x * 512 + tid; i < (size_t)MTOK * PLE / 4; i += (size_t)gridDim.x * 512) { const f32x4 v = p4[i]; u32x2 o = {pk2(v[0], v[1]), pk2(v[2], v[3])}; pb[i] = o; } }
    const bf16_t* OF = (const bf16_t*)a.out + (size_t)MTOK * 512; const bf16_t* OB = OF + (size_t)MTOK * 512;
    const bf16_t* zg = (const bf16_t*)(a.ws + A_ZG); bf16_t* ydn = (bf16_t*)(a.ws + A_YDN);
    const float* gdn = a.in[10];
    const f32x4 g0 = *(const f32x4*)(gdn + (lane & 15) * 8), g1 = *(const f32x4*)(gdn + (lane & 15) * 8 + 4);
    for (int row = blockIdx.x * 8 + w; row < MTOK; row += gridDim.x * 8) {
        const u32x4 f = *(const u32x4*)(OF + (size_t)row * 512 + lane * 8), bb = *(const u32x4*)(OB + (size_t)row * 512 + lane * 8), z = *(const u32x4*)(zg + (size_t)row * 2560 + lane * 8);
        float o[8]; float ss = 0.f;
#pragma unroll
        for (int e = 0; e < 4; ++e) { o[2 * e] = bf_lo(f[e]) + bf_lo(bb[e]); o[2 * e + 1] = bf_hi(f[e]) + bf_hi(bb[e]); ss += o[2 * e] * o[2 * e] + o[2 * e + 1] * o[2 * e + 1]; }
        ss += __shfl_xor(ss, 1); ss += __shfl_xor(ss, 2); ss += __shfl_xor(ss, 4); ss += __shfl_xor(ss, 8);
        const float rstd = rsqrtf(ss * (1.0f / 128.0f) + EPS);
        u32x4 out;
#pragma unroll
        for (int e = 0; e < 4; ++e) { const float ga = e < 2 ? g0[2 * e] : g1[2 * e - 4], gb2 = e < 2 ? g0[2 * e + 1] : g1[2 * e - 3];
            out[e] = pk2(o[2 * e] * rstd * ga * bf_lo(z[e]), o[2 * e + 1] * rstd * gb2 * bf_hi(z[e])); }
        *(u32x4*)(ydn + (size_t)row * 512 + lane * 8) = out;
    }
}
DI void phase12(const Args& a) {
    const int tid = otid(a.wv), lane = tid & 63, w = tid >> 6;
    const float* rss3 = (const float*)(a.ws + OFF_RSS) + 2 * MTOK; const float* gf = a.in[20];
    for (int row = blockIdx.x * 8 + w; row < MTOK; row += gridDim.x * 8) {
        const float rstd = rsqrtf(rss3[row] * (1.0f / 1024.0f) + EPS);
        f32x4* o = (f32x4*)(a.out + (size_t)row * 1024) + lane;
#pragma unroll
        for (int j = 0; j < 4; ++j) { const f32x4 g = *((const f32x4*)gf + lane + 64 * j); f32x4 v = o[64 * j]; v = v * rstd * g; o[64 * j] = v; }
    }
}

#define XB_TMO      128
#define XB_XCNT(j)  (256  + 64 * (j))
#define XB_XSUB(j)  (1280 + 64 * (j))
#define XB_XGEN(j)  (2304 + 64 * (j))
#define XB_TOP      3328
#define XB_TOPGEN   3392
#define XCD_BAR_WORDS 3456
#define XB_SPIN_CAP (1u << 22)
DI unsigned xb_ld(unsigned* p) { return __hip_atomic_load(p, __ATOMIC_RELAXED, __HIP_MEMORY_SCOPE_AGENT); }
DI unsigned xb_add(unsigned* p, unsigned v) { return __hip_atomic_fetch_add(p, v, __ATOMIC_RELAXED, __HIP_MEMORY_SCOPE_AGENT); }
DI unsigned xb_xcc_id() { return (unsigned)__builtin_amdgcn_s_getreg((3 << 11) | 20) & 0xFu; }
#define XB_SPIN(cond, bar) do { unsigned _sp = 0; while (cond) { __builtin_amdgcn_s_sleep(1); \
    if ((++_sp & 255u) == 0u) { if (xb_ld(&(bar)[XB_TMO])) break; if (_sp > XB_SPIN_CAP) { atomicAdd(&(bar)[XB_TMO], 1u); break; } } } } while (0)
struct XcdBarrier { unsigned* bar; unsigned x; volatile LAS unsigned* st; bool leader; };
DI XcdBarrier xcd_barrier_post(unsigned* bar, volatile LAS unsigned* st) {
    XcdBarrier b; b.bar = bar; b.x = xb_xcc_id(); b.st = st; b.leader = threadIdx.x == 0;
    if (threadIdx.x == 0) (void)xb_add(&bar[XB_XCNT(b.x)], 1u);
    return b;
}
DI void xcd_barrier_complete(unsigned* bar, unsigned x, unsigned& nloc, unsigned& nx) {
    const unsigned G = gridDim.x * gridDim.y * gridDim.z;
    unsigned sum, cnt, mine, sp = 0u;
    for (;;) {
        sum = 0u; cnt = 0u; mine = 0u;
#pragma unroll
        for (unsigned j = 0; j < 16; ++j) { const unsigned c = xb_ld(&bar[XB_XCNT(j)]); sum += c; cnt += (c > 0u) ? 1u : 0u; mine = (j == x) ? c : mine; }
        if (sum == G) break;
        __builtin_amdgcn_s_sleep(1);
        if ((++sp & 255u) == 0u) { if (xb_ld(&bar[XB_TMO])) break; if (sp > XB_SPIN_CAP) { atomicAdd(&bar[XB_TMO], 1u); break; } }
    }
    nloc = mine > 0u ? mine : 1u; nx = cnt > 0u ? cnt : 1u;
}
DI void xcd_barrier(const XcdBarrier& b) {
    asm volatile("s_waitcnt vmcnt(0)" ::: "memory");
    __syncthreads();
    if (b.leader) {
        unsigned* bar = b.bar;
        __builtin_amdgcn_s_waitcnt(0);
        unsigned nloc = b.st[0], nx = b.st[1];
        if (nloc == 0u) { xcd_barrier_complete(bar, b.x, nloc, nx); b.st[0] = nloc; b.st[1] = nx; }
        const unsigned old = xb_add(&bar[XB_XSUB(b.x)], 1u);
        const unsigned gen = old / nloc;
        if (old + 1u == (gen + 1u) * nloc) {
            __builtin_amdgcn_fence(__ATOMIC_RELEASE, "agent");
            asm volatile("s_waitcnt vmcnt(0)" ::: "memory");
            const unsigned og = xb_add(&bar[XB_TOP], 1u);
            const unsigned tg = og / nx;
            if (og + 1u == (tg + 1u) * nx) xb_add(&bar[XB_TOPGEN], 1u);
            else XB_SPIN(xb_ld(&bar[XB_TOPGEN]) == tg, bar);
            __builtin_amdgcn_fence(__ATOMIC_ACQUIRE, "agent");
            xb_add(&bar[XB_XGEN(b.x)], 1u);
            asm volatile("s_waitcnt vmcnt(0)" ::: "memory");
        } else {
            XB_SPIN(xb_ld(&bar[XB_XGEN(b.x)]) == gen, bar);
            __builtin_amdgcn_fence(__ATOMIC_ACQUIRE, "agent");
            asm volatile("s_waitcnt vmcnt(0)" ::: "memory");
        }
    }
    __syncthreads();
}

typedef const __attribute__((address_space(4))) Args* KArgP;
DI Args load_args() {
#if defined(__HIP_DEVICE_COMPILE__)
    KArgP p = (KArgP)__builtin_amdgcn_kernarg_segment_ptr(); asm volatile("" : "+s"(p));
    Args r;
#pragma unroll
    for (int i = 0; i < 21; ++i) r.in[i] = p->in[i];
    r.out = p->out; r.ws = p->ws; r.ph_lo = p->ph_lo; r.ph_hi = p->ph_hi; r.wv = 0; r.pad_ = 0; return r;
#else
    return Args{};
#endif
}
__global__ __launch_bounds__(512, 2) void fwd_mega(Args a_in) {
    extern __shared__ __attribute__((aligned(16))) unsigned char smem[];
    LAS unsigned char* lds = (LAS unsigned char*)smem;
    cg::grid_group grid = cg::this_grid();
    const int ph_lo = a_in.ph_lo, ph_hi = a_in.ph_hi;
    const int wv_s = __builtin_amdgcn_readfirstlane((int)(threadIdx.x >> 6));
    volatile LAS unsigned* xst = (volatile LAS unsigned*)(lds + LDS_BYTES - 16);
    if (threadIdx.x == 0) { xst[0] = 0u; xst[1] = 0u; }
    __syncthreads();
    (void)xcd_barrier_post((unsigned*)(a_in.ws + OFF_BAR), xst);
    if (ph_lo < 0) grid.sync();
#define GRID_BARRIER() do { XcdBarrier xb_; xb_.bar = (unsigned*)(load_args().ws + OFF_BAR); xb_.x = xb_xcc_id(); xb_.st = (volatile LAS unsigned*)(lds + LDS_BYTES - 16); xb_.leader = (wv_s == 0) && (olane() == 0); xcd_barrier(xb_); } while (0)
#define RUN_PHASE(PH, ...) do { if (ph_lo <= (PH) && (PH) < ph_hi) { for (int rep_ = 0; rep_ < ((PROBE_PH == (PH)) ? 2 : 1); ++rep_) { { Args a = load_args(); a.wv = wv_s; unsigned char* ws = a.ws; float* rss = (float*)(ws + OFF_RSS); \
        const int G = osg((int)gridDim.x), c = osg((int)blockIdx.x); (void)ws; (void)rss; (void)G; (void)c; __VA_ARGS__ } if ((PH) + 1 < ph_hi || rep_ == 0 && PROBE_PH == (PH)) GRID_BARRIER(); } } } while (0)
    RUN_PHASE(0, phase0(a, lds););
    RUN_PHASE(1, { pg8::StaticOrder S; S.init(MTOK, NPROJ, G, c); pg8::Gemm g{(const bf16_t*)(ws + A_XN), (const bf16_t*)(ws + A_XN), (const bf16_t*)(ws + OFF_WIN), (const bf16_t*)(ws + OFF_WIN), 1024, 16, 16, a.wv};
            EpiProj E{(bf16_t*)(ws + A_PROJA), (bf16_t*)(ws + A_ZG), (float*)(ws + OFF_SMALL)}; pg8::gemm_phase(lds, g, S, E);
            if (G == 256 && c >= 192) { __syncthreads(); p0_weights(a, lds, P0_I_IN, P0_NIT, c - 192, 64); } });
    RUN_PHASE(2, phase2(a););
    RUN_PHASE(3, phase3(a, lds););
    RUN_PHASE(4, phase4(a, lds););
    RUN_PHASE(5, phase5(a););
    RUN_PHASE(6, { pg8::StaticOrder S; S.init(MTOK, 1024, G, c); pg8::Gemm g{(const bf16_t*)a.out + (size_t)3 * MTOK * 512, (const bf16_t*)(ws + A_YDN), (const bf16_t*)(ws + OFF_WAD), (const bf16_t*)(ws + OFF_WAD) + (size_t)1024 * 512, 512, 16, 8, a.wv};
            EpiMerge E{(const bf16_t*)(ws + A_ZG), (bf16_t*)(ws + A_MERGED)}; pg8::gemm_phase(lds, g, S, E); });
    RUN_PHASE(7, { pg8::StaticOrder S; S.init(MTOK, 1024, G, c); pg8::Gemm g{(const bf16_t*)(ws + A_MERGED), (const bf16_t*)(ws + A_MERGED), (const bf16_t*)(ws + OFF_WO), (const bf16_t*)(ws + OFF_WO), 1024, 16, 16, a.wv};
            if (G == 256) { EpiResidDrain<false> E{a.in[0], (bf16_t*)(ws + A_H1B), rss}; pg8::gemm_phase(lds, g, S, E); } else { EpiResid<false> E{a.in[0], (bf16_t*)(ws + A_H1B), rss}; pg8::gemm_phase(lds, g, S, E); } });
    RUN_PHASE(8, { pg8::StaticOrder S; S.init(MTOK, DFF, G, c); pg8::Gemm g{(const bf16_t*)(ws + A_H1B), (const bf16_t*)(ws + A_H1B), (const bf16_t*)(ws + OFF_W1), (const bf16_t*)(ws + OFF_W1), 1024, 16, 16, a.wv};
            EpiFF1 E{rss, (bf16_t*)(ws + A_ACT)}; pg8::gemm_phase(lds, g, S, E); });
    RUN_PHASE(9, { pg8::StaticOrder S; S.init(MTOK, 1024, G, c); pg8::Gemm g{(const bf16_t*)(ws + A_ACT), (const bf16_t*)(ws + A_ACT), (const bf16_t*)(ws + OFF_W2), (const bf16_t*)(ws + OFF_W2), 4096, 64, 64, a.wv};
            if (G == 256) { EpiResidDrain<true> E{(const void*)(ws + A_H1B), (bf16_t*)(ws + A_H2B), rss + MTOK}; pg8::gemm_phase(lds, g, S, E); } else { EpiResid<true> E{(const void*)(ws + A_H1B), (bf16_t*)(ws + A_H2B), rss + MTOK}; pg8::gemm_phase(lds, g, S, E); } });
    if (ph_lo <= 10 && 10 < ph_hi) for (int rep_ = 0; rep_ < ((PROBE_PH == 10) ? 2 : 1); ++rep_) { Args a = load_args(); a.wv = wv_s; unsigned char* ws = a.ws; const int G = osg((int)gridDim.x), c = osg((int)blockIdx.x);
        pg8::StaticOrder S; S.init(MTOK, 1024, G, c); pg8::Gemm g{(const bf16_t*)(ws + OFF_PB), (const bf16_t*)(ws + OFF_PB), (const bf16_t*)(ws + OFF_WPP), (const bf16_t*)(ws + OFF_WPP), 256, 4, 4, a.wv};
        EpiPP E{(bf16_t*)(ws + A_PP)}; pg8::gemm_phase(lds, g, S, E);
    }
    if (gridDim.x == 256) {
        if (ph_lo <= 11 && 11 < ph_hi) { Args a = load_args(); a.wv = wv_s; unsigned char* ws = a.ws; float* rss = (float*)(ws + OFF_RSS); const int G = osg((int)gridDim.x), c = osg((int)blockIdx.x);
            pg8::StaticOrder S; S.init(MTOK, 1024, G, c); pg8::Gemm g{(const bf16_t*)(ws + A_H2B), (const bf16_t*)(ws + A_H2B), (const bf16_t*)(ws + OFF_WPG), (const bf16_t*)(ws + OFF_WPG), 1024, 16, 16, a.wv};
            EpiGateFinal E{rss + MTOK, (const bf16_t*)(ws + A_PP), (const bf16_t*)(ws + A_H2B), a.out, rss + 2 * MTOK, (unsigned*)(ws + OFF_CNT), a.in[20], a.wv}; pg8::gemm_phase(lds, g, S, E); }
    } else {
        RUN_PHASE(11, { pg8::StaticOrder S; S.init(MTOK, 1024, G, c); pg8::Gemm g{(const bf16_t*)(ws + A_H2B), (const bf16_t*)(ws + A_H2B), (const bf16_t*)(ws + OFF_WPG), (const bf16_t*)(ws + OFF_WPG), 1024, 16, 16, a.wv};
                EpiGate E{rss + MTOK, (const bf16_t*)(ws + A_PP), (const bf16_t*)(ws + A_H2B), a.out, rss + 2 * MTOK}; pg8::gemm_phase(lds, g, S, E); });
        RUN_PHASE(12, phase12(a););
    }
    for (int i = 0; i < PROBE_SYNCS; ++i) GRID_BARRIER();
}

extern "C" void kernel_launch(void* const* d_in, const int* in_sizes, int n_in, void* d_out, int out_size, void* d_ws, size_t ws_size, hipStream_t stream) {
    static int grid = 0;
    if (grid == 0) {
        if (n_in != 21 || out_size != MTOK * DM || ws_size < WS_NEED) { fprintf(stderr, "kernel_launch: unexpected shapes (n_in %d out %d ws %zu)\n", n_in, out_size, ws_size); grid = -1; return; }
        int dev = 0, cus = 0, per_cu = 0;
        (void)hipGetDevice(&dev);
        (void)hipDeviceGetAttribute(&cus, hipDeviceAttributeMultiprocessorCount, dev);
        if (hipFuncSetAttribute((const void*)fwd_mega, hipFuncAttributeMaxDynamicSharedMemorySize, LDS_BYTES) != hipSuccess) { fprintf(stderr, "kernel_launch: hipFuncSetAttribute failed\n"); grid = -1; return; }
        if (hipOccupancyMaxActiveBlocksPerMultiprocessor(&per_cu, (const void*)fwd_mega, 512, LDS_BYTES) != hipSuccess || per_cu < 1) per_cu = 1;
        (void)hipGetLastError();
        grid = cus * per_cu;
        if (grid > 256) grid = 256;
        grid &= ~7;
        if (grid < 8) grid = 8;
    }
    if (grid < 0) return;
    Args a{};
    for (int i = 0; i < 21; ++i) a.in[i] = (const float*)d_in[i];
    a.out = (float*)d_out; a.ws = (unsigned char*)d_ws;
    if (hipMemsetAsync((unsigned char*)d_ws + OFF_BAR, 0, XCD_BAR_WORDS * 4, stream) != hipSuccess) { fprintf(stderr, "kernel_launch: memset of the barrier words failed\n"); return; }
#if MK_PER_PHASE
    for (int ph = 0; ph < NPHASE; ++ph) { a.ph_lo = ph; a.ph_hi = ph + 1; hipLaunchKernelGGL(fwd_mega, dim3(grid), dim3(512), LDS_BYTES, stream, a); }
#else
    a.ph_lo = 0; a.ph_hi = NPHASE;
    void* args[] = {&a};
    hipError_t e = hipLaunchCooperativeKernel((const void*)fwd_mega, dim3(grid), dim3(512), args, LDS_BYTES, stream);
    if (e != hipSuccess) fprintf(stderr, "cooperative launch failed: %s (grid %d)\n", hipGetErrorString(e), grid);
#endif
}
```

```cpp
#include <hip/hip_runtime.h>
#include <hip/hip_cooperative_groups.h>
#include <cstdio>
#include <cstdint>
namespace cg = cooperative_groups;

#ifndef PROBE_PH
#define PROBE_PH -1
#endif
#ifndef PROBE_EXTRA
#define PROBE_EXTRA 0
#endif
#ifndef PROBE_SYNCS
#define PROBE_SYNCS 0
#endif
#ifndef MK_PER_PHASE
#define MK_PER_PHASE 0
#endif

#define DI __device__ __forceinline__
#define LAS __attribute__((address_space(3)))
#define GAS __attribute__((address_space(1)))
typedef unsigned short bf16_t;
typedef short bf16x8 __attribute__((ext_vector_type(8)));
typedef float f32x4 __attribute__((ext_vector_type(4)));
typedef float f32x2 __attribute__((ext_vector_type(2)));
typedef unsigned u32x4 __attribute__((ext_vector_type(4)));
typedef unsigned u32x2 __attribute__((ext_vector_type(2)));
typedef __bf16 bf16v2 __attribute__((ext_vector_type(2)));

constexpr int MTOK = 16384, DM = 1024, SEQ = 8192, NH = 4, DFF = 4096, PLE = 256;
constexpr float EPS = 1e-6f;
constexpr int NPROJ = 5888;
constexpr int LDS_BYTES = 147456;
constexpr int NPHASE = 13;

constexpr size_t OFF_RSS = 0;
constexpr size_t OFF_BAR = 196608;
constexpr size_t OFF_CNT = 212992;
constexpr size_t OFF_FLG = 221184;
constexpr size_t OFF_WIN = 262144;
constexpr size_t OFF_WAD = OFF_WIN + 12058624;
constexpr size_t OFF_WO = OFF_WAD + 2097152;
constexpr size_t OFF_W1 = OFF_WO + 2097152;
constexpr size_t OFF_W2 = OFF_W1 + 8388608;
constexpr size_t OFF_WPG = OFF_W2 + 8388608;
constexpr size_t OFF_WPP = OFF_WPG + 2097152;
constexpr size_t OFF_PB = OFF_WPP + 524288;
constexpr size_t OFF_SMALL = OFF_PB + 8388608;
constexpr size_t OFF_GB = OFF_SMALL + 1048576;
constexpr size_t ARENA = OFF_GB + 1048576;
constexpr size_t A_ZG = ARENA;
constexpr size_t A_XN = ARENA + 83886080;
constexpr size_t A_PROJA = ARENA + 117440512;
constexpr size_t A_KTT = A_XN;
constexpr size_t A_OPS = ARENA + 100663296;
constexpr size_t A_YDN = A_OPS;
constexpr size_t A_TMP = ARENA + 117440512;
constexpr size_t A_MERGED = ARENA + 184549376;
constexpr size_t A_H1B = ARENA;
constexpr size_t A_ACT = ARENA + 33554432;
constexpr size_t A_H2B = ARENA + 167772160;
constexpr size_t A_PP = ARENA;
constexpr size_t OFF_RING = OFF_PB;
constexpr int RING_R = 13, RING_SLOT = 6144;
constexpr size_t WS_NEED = 268435456;
constexpr int OPS_TASK = 58368;

struct Args {
    const float* in[21];
    float* out;
    unsigned char* ws;
    int ph_lo, ph_hi;
    int wv, pad_;
};

DI unsigned pk2(float a, float b) { f32x2 v = {a, b}; return __builtin_bit_cast(unsigned, __builtin_convertvector(v, bf16v2)); }
DI float bf_lo(unsigned u) { return __uint_as_float(u << 16); }
DI float bf_hi(unsigned u) { return __uint_as_float(u & 0xffff0000u); }
DI float wave_sum(float v) {
#pragma unroll
    for (int o = 1; o < 64; o <<= 1) v += __shfl_xor(v, o);
    return v;
}
DI float sigmoidf_(float v) { return __builtin_amdgcn_rcpf(1.0f + __expf(-v)); }
DI bf16x8 pack8(f32x4 a, f32x4 b) { u32x4 p = {pk2(a[0], a[1]), pk2(a[2], a[3]), pk2(b[0], b[1]), pk2(b[2], b[3])}; return __builtin_bit_cast(bf16x8, p); }
DI bf16x8 pack8r(f32x4 a, f32x4 b) { u32x4 p = {pk2(a[3], a[2]), pk2(a[1], a[0]), pk2(b[3], b[2]), pk2(b[1], b[0])}; return __builtin_bit_cast(bf16x8, p); }
#define MFMA16(a, b, c) __builtin_amdgcn_mfma_f32_16x16x32_bf16((a), (b), (c), 0, 0, 0)
#define LDS_WAIT() asm volatile("s_waitcnt lgkmcnt(0)" ::: "memory")
DI int olane() { int l = (int)__builtin_amdgcn_mbcnt_hi(~0u, __builtin_amdgcn_mbcnt_lo(~0u, 0u)); asm volatile("" : "+v"(l)); return l; }
DI int otid(int wv) { int t = wv * 64 + olane(); asm volatile("" : "+v"(t)); return t; }
DI int osg(int v) { asm volatile("" : "+s"(v)); return v; }

namespace pg8 {
constexpr int BM = 256, BK = 64, HALF = 128, HTB = HALF * BK * 2, STAGE_BYTES = 8 * HTB, NXCD = 8, WGM = 8;
DI int lds_byte(int r, int c) { const int st = (r >> 4) * 2 + (c >> 5), rr = r & 15, cc = c & 31, ob = rr * 64 + cc * 2; return st * 1024 + (ob ^ (((ob >> 9) & 1) << 5)); }
DI void stage_rc(int b, int& R, int& C) { const int st = b / 1024, sb = b % 1024, swz = sb ^ (((sb >> 9) & 1) << 5); R = (st >> 1) * 16 + swz / 64; C = (st & 1) * 32 + (swz % 64) / 2; }
DI int perm32(int rho) { const int n = rho >> 4, i = rho & 15; return 8 * (i >> 2) + 4 * n + (i & 3); }

struct Unit { int pm, pn; };
struct Gemm { const bf16_t* A; const bf16_t* A2; const bf16_t* Bt; const bf16_t* Bt2; int ld; int nt; int nth; int wv; };

struct StaticOrder {
    int nM, nN, nwg, G, c;
    DI void init(int M, int N, int G_, int c_) { nM = M / BM; nN = N / BM; nwg = nM * nN; G = G_; c = c_; }
    DI bool tile(long L, Unit& u) const {
        if (L >= nwg) return false;
        int wgid = (int)L; { const int q = nwg / NXCD, r = nwg % NXCD, xcd = wgid % NXCD, off = wgid / NXCD; wgid = (xcd < r ? xcd * (q + 1) : r * (q + 1) + (xcd - r) * q) + off; }
        const int nig = WGM * nN, gid = wgid / nig, fm = gid * WGM, gsz = (nM - fm) < WGM ? (nM - fm) : WGM;
        u.pm = fm + ((wgid % nig) % gsz); u.pn = (wgid % nig) / gsz; return true;
    }
    DI bool next(int i, Unit& u) const { return tile((long)i * G + c, u); }
};
template <class Epi, class Sched>
DI void gemm_phase(LAS unsigned char* lds, const Gemm g, const Sched& S, const Epi& E) {
    const int tid = otid(g.wv), wid = __builtin_amdgcn_readfirstlane(tid >> 6), lane = tid & 63, wr = wid >> 2, wc = wid & 3, fr = lane & 15, fq = lane >> 4;
    const int K = g.ld, nt = g.nt, nth = g.nth;
    unsigned voffA[2], voffB[2];
#pragma unroll
    for (int i = 0; i < 2; ++i) { int R, C; stage_rc(tid * 16 + i * 8192, R, C); const int Rb = (R & ~31) + perm32(R & 31);
        voffA[i] = (unsigned)(R * K + C) * 2u; voffB[i] = (unsigned)(Rb * K + C) * 2u; }
    const size_t kstep = (size_t)(BK * 2);
    const size_t hstep = (size_t)HALF * K * 2;
    const size_t tstep = 2 * hstep;
    const unsigned ldsw = (unsigned)wid * 1024u;
    const int aoff = lds_byte(wr * 64 + fr, fq * 8), boff = lds_byte(wc * 32 + fr, fq * 8);
#define PG8_SA(b, h) (((b) * 2 + (h)) * HTB)
#define PG8_SB(b, h) ((4 + (b) * 2 + (h)) * HTB)
#define PG8_STAGE(bufoff, gbase, voff) do { _Pragma("unroll") for (int _i = 0; _i < 2; ++_i) \
        __builtin_amdgcn_global_load_lds((const unsigned*)((const char*)(gbase) + (voff)[_i]), (LAS unsigned*)(lds + (bufoff) + ldsw + _i * 8192), 16, 0, 0); } while (0)
#define PG8_LDA(dst, b, h) do { _Pragma("unroll") for (int m = 0; m < 4; ++m) _Pragma("unroll") for (int k = 0; k < 2; ++k) dst[m][k] = *(const LAS bf16x8*)(lds + PG8_SA(b, h) + aoff + m * 2048 + k * 1024); } while (0)
#define PG8_LDB(dst, b, h) do { _Pragma("unroll") for (int n = 0; n < 2; ++n) _Pragma("unroll") for (int k = 0; k < 2; ++k) dst[n][k] = *(const LAS bf16x8*)(lds + PG8_SB(b, h) + boff + n * 2048 + k * 1024); } while (0)
#define PG8_MMA(ai, bj, At, Bt) do { __builtin_amdgcn_s_setprio(1); _Pragma("unroll") for (int m = 0; m < 4; ++m) _Pragma("unroll") for (int n = 0; n < 2; ++n) _Pragma("unroll") for (int k = 0; k < 2; ++k) \
        acc[ai][bj][m][n] = __builtin_amdgcn_mfma_f32_16x16x32_bf16(Bt[n][k], At[m][k], acc[ai][bj][m][n], 0, 0, 0); __builtin_amdgcn_s_setprio(0); } while (0)
#define PG8_WAIT_V(n) asm volatile("s_waitcnt vmcnt(" #n ")" ::: "memory")
#define PG8_WAIT_L(n) asm volatile("s_waitcnt lgkmcnt(" #n ")" ::: "memory")
#define PG8_BAR __builtin_amdgcn_s_barrier()
#define PG8_SCHED __builtin_amdgcn_sched_barrier(0)
    Unit cur, nxt; int ui = 0;
    if (!S.next(0, cur)) return;
    f32x4 acc[2][2][4][2];
#pragma unroll
    for (int a = 0; a < 2; ++a)
#pragma unroll
        for (int b = 0; b < 2; ++b)
#pragma unroll
            for (int m = 0; m < 4; ++m)
#pragma unroll
                for (int n = 0; n < 2; ++n) acc[a][b][m][n] = (f32x4){0.f, 0.f, 0.f, 0.f};
    bf16x8 At[4][2], B0[2][2], B1[2][2];
    const char* cA = (const char*)g.A + (size_t)cur.pm * tstep; const char* cB = (const char*)g.Bt + (size_t)cur.pn * tstep;
    const long dA2 = (const char*)g.A2 - (const char*)g.A - (long)nth * (long)kstep, dB2 = (const char*)g.Bt2 - (const char*)g.Bt - (long)nth * (long)kstep;
    PG8_STAGE(PG8_SB(0, 0), cB, voffB); PG8_STAGE(PG8_SA(0, 0), cA, voffA); PG8_STAGE(PG8_SB(0, 1), cB + hstep, voffB); PG8_STAGE(PG8_SA(0, 1), cA + hstep, voffA);
    if (wr == 1) PG8_BAR;
    PG8_WAIT_V(4); PG8_BAR;
    PG8_STAGE(PG8_SB(1, 0), cB + kstep, voffB); PG8_STAGE(PG8_SA(1, 0), cA + kstep, voffA); PG8_STAGE(PG8_SB(1, 1), cB + hstep + kstep, voffB);
    PG8_WAIT_V(6); PG8_BAR;
    for (;;) {
        const bool has_next = S.next(ui + 1, nxt);
        const char* nA = has_next ? (const char*)g.A + (size_t)nxt.pm * tstep : cA; const char* nB = has_next ? (const char*)g.Bt + (size_t)nxt.pn * tstep : cB;
        for (int t = 0; t < nt; t += 2) {
            const bool last = (t == nt - 2);
            if constexpr (Epi::HAS_MID) { if (t == nth) { const int l2 = olane(); E.mid(acc, cur, wr, wc, l2 & 15, l2 >> 4); PG8_SCHED; } }
            const char* a1 = cA + (size_t)(t + 1) * kstep + (t + 1 >= nth ? dA2 : 0L);
            const char* a2 = last ? nA : cA + (size_t)(t + 2) * kstep + (t + 2 >= nth ? dA2 : 0L); const char* b2 = last ? nB : cB + (size_t)(t + 2) * kstep + (t + 2 >= nth ? dB2 : 0L);
            const char* a3 = a2 + kstep; const char* b3 = b2 + kstep;
            PG8_LDB(B0, 0, 0); PG8_SCHED; PG8_LDA(At, 0, 0); PG8_STAGE(PG8_SA(1, 1), a1 + hstep, voffA);
            PG8_WAIT_L(8); PG8_BAR; PG8_WAIT_L(0); PG8_MMA(0, 0, At, B0); PG8_BAR; PG8_SCHED;
            PG8_LDB(B1, 0, 1); PG8_STAGE(PG8_SB(0, 0), b2, voffB);
            PG8_BAR; PG8_WAIT_L(0); PG8_MMA(0, 1, At, B1); PG8_BAR;
            PG8_LDA(At, 0, 1); PG8_STAGE(PG8_SA(0, 0), a2, voffA);
            PG8_BAR; PG8_WAIT_L(0); PG8_MMA(1, 0, At, B0); PG8_BAR; PG8_SCHED;
            PG8_STAGE(PG8_SB(0, 1), b2 + hstep, voffB);
            PG8_WAIT_V(6); PG8_BAR; PG8_MMA(1, 1, At, B1); PG8_BAR;
            PG8_LDB(B0, 1, 0); PG8_SCHED; PG8_LDA(At, 1, 0); PG8_STAGE(PG8_SA(0, 1), a2 + hstep, voffA);
            PG8_WAIT_L(8); PG8_BAR; PG8_WAIT_L(0); PG8_MMA(0, 0, At, B0); PG8_BAR; PG8_SCHED;
            PG8_LDB(B1, 1, 1); PG8_STAGE(PG8_SB(1, 0), b3, voffB);
            PG8_BAR; PG8_WAIT_L(0); PG8_MMA(0, 1, At, B1); PG8_BAR;
            PG8_LDA(At, 1, 1); PG8_STAGE(PG8_SA(1, 0), a3, voffA);
            PG8_BAR; PG8_WAIT_L(0); PG8_MMA(1, 0, At, B0); PG8_BAR; PG8_SCHED;
            PG8_STAGE(PG8_SB(1, 1), b3 + hstep, voffB);
            PG8_WAIT_V(6); PG8_BAR; PG8_MMA(1, 1, At, B1); PG8_BAR;
        }
        if constexpr (!Epi::AFTER_DRAIN) { const int l2 = olane(); E(acc, cur, wr, wc, l2 & 15, l2 >> 4); }
        if (!has_next) break;
#pragma unroll
        for (int a = 0; a < 2; ++a)
#pragma unroll
            for (int b = 0; b < 2; ++b)
#pragma unroll
                for (int m = 0; m < 4; ++m)
#pragma unroll
                    for (int n = 0; n < 2; ++n) acc[a][b][m][n] = (f32x4){0.f, 0.f, 0.f, 0.f};
        cur = nxt; cA = nA; cB = nB; ++ui;
    }
    PG8_WAIT_V(0);
    if (wr == 0) PG8_BAR;
    PG8_BAR;
    if constexpr (Epi::AFTER_DRAIN) { const int l2 = olane(); E.fused(acc, cur, wr, wc, l2 & 15, l2 >> 4, lds); }
#undef PG8_SA
#undef PG8_SB
#undef PG8_STAGE
#undef PG8_LDA
#undef PG8_LDB
#undef PG8_MMA
#undef PG8_WAIT_V
#undef PG8_WAIT_L
#undef PG8_BAR
#undef PG8_SCHED
}
}
using pg8::Unit;
typedef f32x4 AccT[2][2][4][2];

DI void rowss_add(float* rss, int row, float s, int fq) {
    s += __shfl_xor(s, 16); s += __shfl_xor(s, 32);
    if (fq == 0) atomicAdd(rss + row, s);
}

struct EpiProj {
    static constexpr bool HAS_MID = false;
    static constexpr bool AFTER_DRAIN = false;
    bf16_t* proja; bf16_t* zg; float* small;
    DI void operator()(const AccT& acc, const Unit& u, int wr, int wc, int fr, int fq) const {
        const int row0 = u.pm * 256 + wr * 64 + fr, pn = u.pn;
        if (pn == 22) {
            if (wc == 0 && fq < 2) {
#pragma unroll
                for (int ai = 0; ai < 2; ++ai)
#pragma unroll
                    for (int m = 0; m < 4; ++m) { float* d = small + (size_t)(row0 + ai * 128 + m * 16) * 16 + 8 * fq;
                        *(f32x4*)d = acc[ai][0][m][0]; *(f32x4*)(d + 4) = acc[ai][0][m][1]; }
            }
            return;
        }
        bf16_t* base; int ld, colt, act;
        if (pn < 12) { base = proja; ld = 3072; colt = pn * 256; act = 0; }
        else if (pn < 14) { base = zg; ld = 2560; colt = (pn - 12) * 256; act = 1; }
        else { base = zg; ld = 2560; colt = 512 + (pn - 14) * 256; act = 2; }
#pragma unroll
        for (int ai = 0; ai < 2; ++ai)
#pragma unroll
            for (int m = 0; m < 4; ++m) { bf16_t* rowp = base + (size_t)(row0 + ai * 128 + m * 16) * ld + colt + wc * 32 + 8 * fq;
#pragma unroll
                for (int bj = 0; bj < 2; ++bj) { f32x4 v0 = acc[ai][bj][m][0], v1 = acc[ai][bj][m][1];
                    if (act) {
#pragma unroll
                        for (int j = 0; j < 4; ++j) { const float s0 = sigmoidf_(v0[j]), s1 = sigmoidf_(v1[j]); v0[j] = act == 1 ? v0[j] * s0 : s0; v1[j] = act == 1 ? v1[j] * s1 : s1; } }
                    u32x4 w = {pk2(v0[0], v0[1]), pk2(v0[2], v0[3]), pk2(v1[0], v1[1]), pk2(v1[2], v1[3])};
                    *(u32x4*)(rowp + bj * 128) = w; } }
    }
};
struct EpiMerge {
    static constexpr bool HAS_MID = true;
    static constexpr bool AFTER_DRAIN = false;
    const bf16_t* zg; bf16_t* merged;
    DI void mid(AccT& acc, const Unit& u, int wr, int wc, int fr, int fq) const {
        const int row0 = u.pm * 256 + wr * 64 + fr, col0 = u.pn * 256 + wc * 32 + 8 * fq;
#pragma unroll
        for (int ai = 0; ai < 2; ++ai)
#pragma unroll
            for (int m = 0; m < 4; ++m) { const size_t row = row0 + ai * 128 + m * 16;
                asm volatile("" ::: "memory");
#pragma unroll
                for (int bj = 0; bj < 2; ++bj) { const int col = col0 + bj * 128;
                    const u32x4 ga = *(const u32x4*)(zg + row * 2560 + 512 + col), gd = *(const u32x4*)(zg + row * 2560 + 1536 + col);
#pragma unroll
                    for (int e = 0; e < 4; ++e) { const float r0 = bf_lo(ga[e]) * __builtin_amdgcn_rcpf(fmaxf(bf_lo(gd[e]), 1e-30f)), r1 = bf_hi(ga[e]) * __builtin_amdgcn_rcpf(fmaxf(bf_hi(gd[e]), 1e-30f));
                        acc[ai][bj][m][e >> 1][(e & 1) * 2] *= r0; acc[ai][bj][m][e >> 1][(e & 1) * 2 + 1] *= r1; } } }
    }
    DI void operator()(const AccT& acc, const Unit& u, int wr, int wc, int fr, int fq) const {
        const int row0 = u.pm * 256 + wr * 64 + fr, col0 = u.pn * 256 + wc * 32 + 8 * fq;
#pragma unroll
        for (int ai = 0; ai < 2; ++ai)
#pragma unroll
            for (int m = 0; m < 4; ++m) { const size_t row = row0 + ai * 128 + m * 16;
#pragma unroll
                for (int bj = 0; bj < 2; ++bj) { const int col = col0 + bj * 128;
                    const u32x4 gw = *(const u32x4*)(zg + row * 2560 + 1536 + col);
                    const f32x4 g0 = {fmaxf(bf_lo(gw[0]), 1e-30f), fmaxf(bf_hi(gw[0]), 1e-30f), fmaxf(bf_lo(gw[1]), 1e-30f), fmaxf(bf_hi(gw[1]), 1e-30f)}, g1 = {fmaxf(bf_lo(gw[2]), 1e-30f), fmaxf(bf_hi(gw[2]), 1e-30f), fmaxf(bf_lo(gw[3]), 1e-30f), fmaxf(bf_hi(gw[3]), 1e-30f)};
                    const f32x4 v0 = acc[ai][bj][m][0] * g0, v1 = acc[ai][bj][m][1] * g1;
                    u32x4 w = {pk2(v0[0], v0[1]), pk2(v0[2], v0[3]), pk2(v1[0], v1[1]), pk2(v1[2], v1[3])};
                    *(u32x4*)(merged + row * 1024 + col) = w; } }
    }
};
template <bool BASE_BF16>
struct EpiResid {
    static constexpr bool HAS_MID = false;
    static constexpr bool AFTER_DRAIN = false;
    const void* base; bf16_t* hb; float* rss;
    DI void operator()(const AccT& acc, const Unit& u, int wr, int wc, int fr, int fq) const {
        const int row0 = u.pm * 256 + wr * 64 + fr, col0 = u.pn * 256 + wc * 32 + 8 * fq;
#pragma unroll
        for (int ai = 0; ai < 2; ++ai)
#pragma unroll
            for (int m = 0; m < 4; ++m) { const size_t row = row0 + ai * 128 + m * 16; float ss = 0.f;
#pragma unroll
                for (int bj = 0; bj < 2; ++bj) { const size_t o = row * 1024 + col0 + bj * 128;
                    f32x4 b0, b1;
                    if (BASE_BF16) { const u32x4 bw = *(const u32x4*)((const bf16_t*)base + o); b0 = (f32x4){bf_lo(bw[0]), bf_hi(bw[0]), bf_lo(bw[1]), bf_hi(bw[1])}; b1 = (f32x4){bf_lo(bw[2]), bf_hi(bw[2]), bf_lo(bw[3]), bf_hi(bw[3])}; }
                    else { b0 = *(const f32x4*)((const float*)base + o); b1 = *(const f32x4*)((const float*)base + o + 4); }
                    const f32x4 v0 = b0 + acc[ai][bj][m][0], v1 = b1 + acc[ai][bj][m][1];
                    u32x4 w = {pk2(v0[0], v0[1]), pk2(v0[2], v0[3]), pk2(v1[0], v1[1]), pk2(v1[2], v1[3])};
                    *(u32x4*)(hb + o) = w;
#pragma unroll
                    for (int j = 0; j < 4; ++j) ss += v0[j] * v0[j] + v1[j] * v1[j]; }
                rowss_add(rss, (int)row, ss, fq); }
    }
};
template <bool BASE_BF16>
struct EpiResidDrain {
    static constexpr bool HAS_MID = false;
    static constexpr bool AFTER_DRAIN = true;
    const void* base; bf16_t* hb; float* rss;
    DI void operator()(const AccT&, const Unit&, int, int, int, int) const {}
    DI void fused(AccT& acc, const Unit& u, int wr, int wc, int fr, int fq, LAS unsigned char* lds) const {
        const int row0 = u.pm * 256 + wr * 64 + fr, col0 = u.pn * 256 + wc * 32 + 8 * fq;
        LAS float* PS = (LAS float*)lds;
#pragma unroll
        for (int ai = 0; ai < 2; ++ai)
#pragma unroll
            for (int m = 0; m < 4; ++m) { const size_t row = row0 + ai * 128 + m * 16; float ss = 0.f;
#pragma unroll
                for (int bj = 0; bj < 2; ++bj) { const size_t o = row * 1024 + col0 + bj * 128;
                    f32x4 b0, b1;
                    if (BASE_BF16) { const u32x4 bw = *(const u32x4*)((const bf16_t*)base + o); b0 = (f32x4){bf_lo(bw[0]), bf_hi(bw[0]), bf_lo(bw[1]), bf_hi(bw[1])}; b1 = (f32x4){bf_lo(bw[2]), bf_hi(bw[2]), bf_lo(bw[3]), bf_hi(bw[3])}; }
                    else { b0 = *(const f32x4*)((const float*)base + o); b1 = *(const f32x4*)((const float*)base + o + 4); }
                    const f32x4 v0 = b0 + acc[ai][bj][m][0], v1 = b1 + acc[ai][bj][m][1];
                    u32x4 w = {pk2(v0[0], v0[1]), pk2(v0[2], v0[3]), pk2(v1[0], v1[1]), pk2(v1[2], v1[3])};
                    *(u32x4*)(hb + o) = w;
#pragma unroll
                    for (int j = 0; j < 4; ++j) ss += v0[j] * v0[j] + v1[j] * v1[j]; }
                ss += __shfl_xor(ss, 16); ss += __shfl_xor(ss, 32);
                if (fq == 0) PS[(ai * 128 + wr * 64 + m * 16 + fr) * 4 + wc] = ss; }
        __syncthreads();
        const int t_ = (wr * 4 + wc) * 64 + fq * 16 + fr;
        if (t_ < 256) { const f32x4 p4 = *(const LAS f32x4*)(PS + t_ * 4); atomicAdd(rss + u.pm * 256 + t_, (p4[0] + p4[1]) + (p4[2] + p4[3])); }
    }
};
struct EpiFF1 {
    static constexpr bool HAS_MID = false;
    static constexpr bool AFTER_DRAIN = false;
    const float* rss; bf16_t* act;
    DI void operator()(const AccT& acc, const Unit& u, int wr, int wc, int fr, int fq) const {
        const int row0 = u.pm * 256 + wr * 64 + fr, col0 = u.pn * 256 + wc * 32 + 8 * fq;
#pragma unroll
        for (int ai = 0; ai < 2; ++ai)
#pragma unroll
            for (int m = 0; m < 4; ++m) { const size_t row = row0 + ai * 128 + m * 16; const float rstd = rsqrtf(rss[row] * (1.0f / 1024.0f) + EPS);
#pragma unroll
                for (int bj = 0; bj < 2; ++bj) { f32x4 v0 = acc[ai][bj][m][0] * rstd, v1 = acc[ai][bj][m][1] * rstd;
#pragma unroll
                    for (int j = 0; j < 4; ++j) { const float a0 = fmaxf(v0[j], 0.f), a1 = fmaxf(v1[j], 0.f); v0[j] = a0 * a0; v1[j] = a1 * a1; }
                    u32x4 w = {pk2(v0[0], v0[1]), pk2(v0[2], v0[3]), pk2(v1[0], v1[1]), pk2(v1[2], v1[3])};
                    *(u32x4*)(act + row * 4096 + col0 + bj * 128) = w; } }
    }
};
struct EpiPP {
    static constexpr bool HAS_MID = false;
    static constexpr bool AFTER_DRAIN = false;
    bf16_t* pp;
    DI void operator()(const AccT& acc, const Unit& u, int wr, int wc, int fr, int fq) const {
        const int row0 = u.pm * 256 + wr * 64 + fr, col0 = u.pn * 256 + wc * 32 + 8 * fq;
#pragma unroll
        for (int ai = 0; ai < 2; ++ai)
#pragma unroll
            for (int m = 0; m < 4; ++m) { const size_t row = row0 + ai * 128 + m * 16;
#pragma unroll
                for (int bj = 0; bj < 2; ++bj) { const f32x4 v0 = acc[ai][bj][m][0], v1 = acc[ai][bj][m][1];
                    u32x4 w = {pk2(v0[0], v0[1]), pk2(v0[2], v0[3]), pk2(v1[0], v1[1]), pk2(v1[2], v1[3])};
                    *(u32x4*)(pp + row * 1024 + col0 + bj * 128) = w; } }
    }
};
struct EpiGate {
    static constexpr bool HAS_MID = false;
    static constexpr bool AFTER_DRAIN = false;
    const float* rss2; const bf16_t* pp; const bf16_t* hin; float* h; float* rss3;
    DI void operator()(const AccT& acc, const Unit& u, int wr, int wc, int fr, int fq) const {
        const int row0 = u.pm * 256 + wr * 64 + fr, col0 = u.pn * 256 + wc * 32 + 8 * fq;
#pragma unroll
        for (int ai = 0; ai < 2; ++ai)
#pragma unroll
            for (int m = 0; m < 4; ++m) { const size_t row = row0 + ai * 128 + m * 16; const float rstd = rsqrtf(rss2[row] * (1.0f / 1024.0f) + EPS); float ss = 0.f;
#pragma unroll
                for (int bj = 0; bj < 2; ++bj) { const size_t o = row * 1024 + col0 + bj * 128;
                    const u32x4 pw = *(const u32x4*)(pp + o);
                    const f32x4 p0 = {bf_lo(pw[0]), bf_hi(pw[0]), bf_lo(pw[1]), bf_hi(pw[1])}, p1 = {bf_lo(pw[2]), bf_hi(pw[2]), bf_lo(pw[3]), bf_hi(pw[3])};
                    const u32x4 hw = *(const u32x4*)(hin + o);
                    f32x4 v0 = {bf_lo(hw[0]), bf_hi(hw[0]), bf_lo(hw[1]), bf_hi(hw[1])}, v1 = {bf_lo(hw[2]), bf_hi(hw[2]), bf_lo(hw[3]), bf_hi(hw[3])};
#pragma unroll
                    for (int j = 0; j < 4; ++j) { v0[j] += sigmoidf_(acc[ai][bj][m][0][j] * rstd) * p0[j]; v1[j] += sigmoidf_(acc[ai][bj][m][1][j] * rstd) * p1[j]; ss += v0[j] * v0[j] + v1[j] * v1[j]; }
                    *(f32x4*)(h + o) = v0; *(f32x4*)(h + o + 4) = v1; }
                rowss_add(rss3, (int)row, ss, fq); }
    }
};

struct EpiGateFinal {
    static constexpr bool HAS_MID = false;
    static constexpr bool AFTER_DRAIN = true;
    const float* rss2; const bf16_t* pp; const bf16_t* h; float* out; float* rss3; unsigned* cnt; const float* gfin; int wv;
    DI void operator()(const AccT&, const Unit&, int, int, int, int) const {}
    DI void fused(AccT& acc, const Unit& u, int wr, int wc, int fr, int fq, LAS unsigned char* lds) const {
        const int row0 = u.pm * 256 + wr * 64 + fr, col0 = u.pn * 256 + wc * 32 + 8 * fq;
        LAS float* PS = (LAS float*)lds;
#pragma unroll
        for (int ai = 0; ai < 2; ++ai)
#pragma unroll
            for (int m = 0; m < 4; ++m) { const size_t row = row0 + ai * 128 + m * 16; const float rstd = rsqrtf(rss2[row] * (1.0f / 1024.0f) + EPS); float ss = 0.f;
#pragma unroll
                for (int bj = 0; bj < 2; ++bj) { const size_t o = row * 1024 + col0 + bj * 128;
                    const u32x4 pw = *(const u32x4*)(pp + o);
                    const f32x4 p0 = {bf_lo(pw[0]), bf_hi(pw[0]), bf_lo(pw[1]), bf_hi(pw[1])}, p1 = {bf_lo(pw[2]), bf_hi(pw[2]), bf_lo(pw[3]), bf_hi(pw[3])};
                    const u32x4 hw = *(const u32x4*)(h + o);
                    f32x4 v0 = {bf_lo(hw[0]), bf_hi(hw[0]), bf_lo(hw[1]), bf_hi(hw[1])}, v1 = {bf_lo(hw[2]), bf_hi(hw[2]), bf_lo(hw[3]), bf_hi(hw[3])};
#pragma unroll
                    for (int j = 0; j < 4; ++j) { v0[j] += sigmoidf_(acc[ai][bj][m][0][j] * rstd) * p0[j]; v1[j] += sigmoidf_(acc[ai][bj][m][1][j] * rstd) * p1[j]; ss += v0[j] * v0[j] + v1[j] * v1[j]; }
                    acc[ai][bj][m][0] = v0; acc[ai][bj][m][1] = v1; }
                ss += __shfl_xor(ss, 16); ss += __shfl_xor(ss, 32);
                if (fq == 0) PS[(ai * 128 + wr * 64 + m * 16 + fr) * 4 + wc] = ss; }
        __syncthreads();
        { const int t_ = (wr * 4 + wc) * 64 + fq * 16 + fr;
          if (t_ < 256) { const f32x4 p4 = *(const LAS f32x4*)(PS + t_ * 4); atomicAdd(rss3 + u.pm * 256 + t_, (p4[0] + p4[1]) + (p4[2] + p4[3])); } }
        asm volatile("s_waitcnt vmcnt(0)" ::: "memory");
        __syncthreads();
        if (wv == 0 && olane() == 0) {
            __hip_atomic_fetch_add(cnt + 16 * u.pm, 1u, __ATOMIC_RELEASE, __HIP_MEMORY_SCOPE_AGENT);
            unsigned sp = 0;
            while (__hip_atomic_load(cnt + 16 * u.pm, __ATOMIC_RELAXED, __HIP_MEMORY_SCOPE_AGENT) < 4u) { __builtin_amdgcn_s_sleep(1); if (++sp > (1u << 22)) break; }
            __builtin_amdgcn_fence(__ATOMIC_ACQUIRE, "agent");
            asm volatile("s_waitcnt vmcnt(0)" ::: "memory");
        }
        __syncthreads();
#pragma unroll
        for (int ai = 0; ai < 2; ++ai)
#pragma unroll
            for (int m = 0; m < 4; ++m) { const size_t row = row0 + ai * 128 + m * 16;
                const float rstd3 = rsqrtf(__hip_atomic_load(rss3 + row, __ATOMIC_RELAXED, __HIP_MEMORY_SCOPE_AGENT) * (1.0f / 1024.0f) + EPS);
#pragma unroll
                for (int bj = 0; bj < 2; ++bj) { const size_t o = row * 1024 + col0 + bj * 128; const int col = col0 + bj * 128;
                    const f32x4 g0 = *(const f32x4*)(gfin + col), g1 = *(const f32x4*)(gfin + col + 4);
                    *(f32x4*)(out + o) = acc[ai][bj][m][0] * rstd3 * g0; *(f32x4*)(out + o + 4) = acc[ai][bj][m][1] * rstd3 * g1; } }
    }
};

DI int win_colmap(int j) { return j < 3584 ? j : (j < 5632 ? j + 16 : (j < 5648 ? j - 2048 : -1)); }
template <int MODE>
DI void tr_item(const float* W, int ldw, int K, bf16_t* WT, int row_off, const float* gain, LAS float* scr, int item, int nblk, int lane) {
    const int kb = item / nblk, nb = item % nblk, k0 = 64 * kb, n0 = 32 * nb;
    const int j = n0 + (lane & 31);
    const int src = MODE == 1 ? win_colmap(j) : j;
    float tv[32];
#pragma unroll
    for (int i = 0; i < 32; ++i) { const int kk = 2 * i + (lane >> 5); tv[i] = W[(size_t)(k0 + kk) * ldw + (src >= 0 ? src : 0)]; }
    if (gain) {
#pragma unroll
        for (int i = 0; i < 32; ++i) tv[i] *= gain[k0 + 2 * i + (lane >> 5)]; }
#pragma unroll
    for (int i = 0; i < 32; ++i) { const int kk = 2 * i + (lane >> 5); scr[kk * 33 + (lane & 31)] = src >= 0 ? tv[i] : 0.f; }
    LDS_WAIT();
    const int c = lane & 7;
#pragma unroll
    for (int jj = 0; jj < 4; ++jj) { const int n = (lane >> 3) + 8 * jj; const LAS float* s = scr + (8 * c) * 33 + n;
        u32x4 o = {pk2(s[0], s[33]), pk2(s[66], s[99]), pk2(s[132], s[165]), pk2(s[198], s[231])};
        *(u32x4*)(WT + (size_t)(row_off + n0 + n) * K + k0 + 8 * c) = o; }
    LDS_WAIT();
}
DI void p0_weights(const Args& a, LAS unsigned char* lds, int it0, int it1, int vc, int nvc) {
    const int tid = otid(a.wv), lane = tid & 63, w = tid >> 6;
    unsigned char* ws = a.ws;
    LAS float* scr = (LAS float*)(lds + w * 8704);
    constexpr int I_IN = 16 * 184, I_A = 8 * 32, I_O = 16 * 32, I_1 = 16 * 128, I_2 = 64 * 32;
    for (int it = it0 + vc * 8 + w; it < it1; it += nvc * 8) {
        int r = it;
        if (r < I_IN) { tr_item<1>(a.in[3], 5648, 1024, (bf16_t*)(ws + OFF_WIN), 0, nullptr, scr, r, 184, lane); continue; } r -= I_IN;
        if (r < I_A) { tr_item<0>(a.in[11], 1024, 512, (bf16_t*)(ws + OFF_WAD), 0, nullptr, scr, r, 32, lane); continue; } r -= I_A;
        if (r < I_A) { tr_item<0>(a.in[12], 1024, 512, (bf16_t*)(ws + OFF_WAD), 1024, nullptr, scr, r, 32, lane); continue; } r -= I_A;
        if (r < I_O) { tr_item<0>(a.in[13], 1024, 1024, (bf16_t*)(ws + OFF_WO), 0, nullptr, scr, r, 32, lane); continue; } r -= I_O;
        if (r < I_1) { tr_item<0>(a.in[15], 4096, 1024, (bf16_t*)(ws + OFF_W1), 0, a.in[14], scr, r, 128, lane); continue; } r -= I_1;
        if (r < I_2) { tr_item<0>(a.in[16], 1024, 4096, (bf16_t*)(ws + OFF_W2), 0, nullptr, scr, r, 32, lane); continue; } r -= I_2;
        if (r < I_O) { tr_item<0>(a.in[18], 1024, 1024, (bf16_t*)(ws + OFF_WPG), 0, a.in[17], scr, r, 32, lane); continue; } r -= I_O;
        tr_item<0>(a.in[19], 1024, 256, (bf16_t*)(ws + OFF_WPP), 0, nullptr, scr, r, 32, lane);
    }
}
constexpr int P0_I_IN = 16 * 184, P0_NIT = 16 * 184 + 2 * 8 * 32 + 16 * 32 + 16 * 128 + 64 * 32 + 16 * 32 + 4 * 32;
DI void phase0(const Args& a, LAS unsigned char* lds) {
    const int tid = otid(a.wv), lane = tid & 63, w = tid >> 6;
    const int gw = blockIdx.x * 8 + w, NGW = gridDim.x * 8;
    unsigned char* ws = a.ws;
    p0_weights(a, lds, 0, gridDim.x == 256 ? P0_I_IN : P0_NIT, blockIdx.x, gridDim.x);
    const float* x = a.in[0]; const float* gm = a.in[2]; bf16_t* xn = (bf16_t*)(ws + A_XN);
    for (int row0 = gw * 2; row0 < MTOK; row0 += NGW * 2) {
        f32x4 v[2][4]; float s[2] = {0.f, 0.f};
#pragma unroll
        for (int r = 0; r < 2; ++r) { const f32x4* xr = (const f32x4*)(x + (size_t)(row0 + r) * 1024) + lane;
#pragma unroll
            for (int j = 0; j < 4; ++j) v[r][j] = xr[64 * j]; }
#pragma unroll
        for (int r = 0; r < 2; ++r)
#pragma unroll
            for (int j = 0; j < 4; ++j) s[r] += (v[r][j][0] * v[r][j][0] + v[r][j][1] * v[r][j][1]) + (v[r][j][2] * v[r][j][2] + v[r][j][3] * v[r][j][3]);
#pragma unroll
        for (int o = 1; o < 64; o <<= 1) { s[0] += __shfl_xor(s[0], o); s[1] += __shfl_xor(s[1], o); }
#pragma unroll
        for (int r = 0; r < 2; ++r) { const float rstd = rsqrtf(s[r] * (1.0f / 1024.0f) + EPS);
            u32x2* o8 = (u32x2*)(xn + (size_t)(row0 + r) * 1024) + lane;
#pragma unroll
            for (int j = 0; j < 4; ++j) { const f32x4 g = *((const f32x4*)gm + lane + 64 * j);
                u32x2 o = {pk2(v[r][j][0] * rstd * g[0], v[r][j][1] * rstd * g[1]), pk2(v[r][j][2] * rstd * g[2], v[r][j][3] * rstd * g[3])}; o8[64 * j] = o; } }
    }
    { float* rss = (float*)(ws + OFF_RSS); for (int i = blockIdx.x * 512 + tid; i < 3 * MTOK; i += gridDim.x * 512) rss[i] = 0.f;
      unsigned* cnt = (unsigned*)(ws + OFF_CNT); for (int i = blockIdx.x * 512 + tid; i < 1024; i += gridDim.x * 512) cnt[i] = 0u;
      unsigned* flg = (unsigned*)(ws + OFF_FLG); for (int i = blockIdx.x * 512 + tid; i < 4096; i += gridDim.x * 512) flg[i] = 0u; }
}

DI float softplusf_(float x) { return fmaxf(x, 0.f) + log1pf(__expf(-fabsf(x))); }
DI float siluf_(float v) { return v * sigmoidf_(v); }
template <int KIND>
DI void p2_head(const Args& a, int b, int s0, int h, int lane) {
    const bf16_t* proja = (const bf16_t*)(a.ws + A_PROJA);
    bf16_t* QT = (bf16_t*)a.out; bf16_t* KT = QT + (size_t)MTOK * 512; bf16_t* VT = KT + (size_t)MTOK * 512; bf16_t* KTT = (bf16_t*)(a.ws + A_KTT);
    const int ch = KIND * 512 + h * 128 + 2 * lane;
    const float* cw = a.in[5];
    const float w00 = cw[ch], w01 = cw[ch + 1], w10 = cw[1536 + ch], w11 = cw[1536 + ch + 1], w20 = cw[3072 + ch], w21 = cw[3072 + ch + 1];
    const unsigned* src = (const unsigned*)(proja + (size_t)b * SEQ * 3072 + 1536 + ch);
    unsigned rw[34];
#pragma unroll
    for (int t = 0; t < 34; ++t) { const int s = s0 - 1 + t; rw[t] = (s >= 0 && s < SEQ) ? src[(size_t)s * 1536] : 0u; }
    float lo[32], hi[32], ss[32];
#pragma unroll
    for (int t = 0; t < 32; ++t) {
        lo[t] = siluf_(bf_lo(rw[t]) * w00 + bf_lo(rw[t + 1]) * w10 + bf_lo(rw[t + 2]) * w20);
        hi[t] = siluf_(bf_hi(rw[t]) * w01 + bf_hi(rw[t + 1]) * w11 + bf_hi(rw[t + 2]) * w21);
        ss[t] = lo[t] * lo[t] + hi[t] * hi[t];
    }
    if (KIND < 2) {
#pragma unroll
        for (int o = 1; o < 64; o <<= 1)
#pragma unroll
            for (int t = 0; t < 32; ++t) ss[t] += __shfl_xor(ss[t], o);
#pragma unroll
        for (int t = 0; t < 32; ++t) { const float rn = rsqrtf(ss[t] + EPS) * (KIND == 0 ? 0.08838834764831845f : 1.0f); lo[t] *= rn; hi[t] *= rn; }
    }
#pragma unroll
    for (int t = 0; t < 32; ++t) {
        const size_t tok = (size_t)b * SEQ + s0 + t;
        if (KIND == 2) { *(unsigned*)(VT + tok * 512 + h * 128 + 2 * lane) = pk2(lo[t], hi[t]); }
        else { const int d = 2 * lane, d32 = d & 31, pos = (d & ~31) + ((d32 >> 2) & 3) * 8 + (d32 >> 4) * 4 + (d32 & 3);
            *(unsigned*)((KIND == 0 ? QT : KT) + tok * 512 + h * 128 + pos) = pk2(lo[t], hi[t]); }
    }
    if (KIND == 1) {
        bf16_t* r0 = KTT + ((size_t)((b * 4 + h) * 128 + 2 * lane) * SEQ + s0);
        bf16_t* r1 = r0 + SEQ;
#pragma unroll
        for (int q4 = 0; q4 < 4; ++q4) { u32x4 o0, o1;
#pragma unroll
            for (int e = 0; e < 4; ++e) { const int p = q4 * 8 + e * 2, t0 = ((p & 7) >> 2) * 16 + (p >> 3) * 4 + (p & 3), t1 = t0 + 1;
                o0[e] = pk2(lo[t0], lo[t1]); o1[e] = pk2(hi[t0], hi[t1]); }
            *(u32x4*)(r0 + q4 * 8) = o0; *(u32x4*)(r1 + q4 * 8) = o1; }
    }
}
DI void p2_mixa(const Args& a, int b, int s0, int blk, int lane) {
    const bf16_t* proja = (const bf16_t*)(a.ws + A_PROJA);
    bf16_t* YA = (bf16_t*)a.out + (size_t)3 * MTOK * 512;
    const int c = blk * 128 + 2 * lane;
    const float* cw = a.in[4];
    const float w00 = cw[c], w01 = cw[c + 1], w10 = cw[512 + c], w11 = cw[512 + c + 1], w20 = cw[1024 + c], w21 = cw[1024 + c + 1];
    const unsigned* src = (const unsigned*)(proja + (size_t)b * SEQ * 3072 + c);
    float p0 = 0.f, p1 = 0.f, c0, c1;
    if (s0 > 0) { const unsigned bb = src[(size_t)(s0 - 1) * 1536], xx = src[(size_t)(s0 - 1) * 1536 + 512]; p0 = bf_lo(bb) * bf_lo(xx); p1 = bf_hi(bb) * bf_hi(xx); }
    { const unsigned bb = src[(size_t)s0 * 1536], xx = src[(size_t)s0 * 1536 + 512]; c0 = bf_lo(bb) * bf_lo(xx); c1 = bf_hi(bb) * bf_hi(xx); }
#pragma unroll 4
    for (int t = 0; t < 32; ++t) {
        const int s = s0 + t; float n0 = 0.f, n1 = 0.f;
        if (s + 1 < SEQ) { const unsigned bb = src[(size_t)(s + 1) * 1536], xx = src[(size_t)(s + 1) * 1536 + 512]; n0 = bf_lo(bb) * bf_lo(xx); n1 = bf_hi(bb) * bf_hi(xx); }
        const unsigned cc = src[(size_t)s * 1536 + 256];
        const float y0 = bf_lo(cc) * (p0 * w00 + c0 * w10 + n0 * w20), y1 = bf_hi(cc) * (p1 * w01 + c1 * w11 + n1 * w21);
        *(unsigned*)(YA + ((size_t)b * SEQ + s) * 512 + c) = pk2(y0, y1);
        p0 = c0; p1 = c1; c0 = n0; c1 = n1;
    }
}
DI void phase2(const Args& a) {
    const int tid = otid(a.wv), lane = tid & 63, w = tid >> 6;
    { const float* sm = (const float*)(a.ws + OFF_SMALL); float* gb = (float*)(a.ws + OFF_GB);
      for (int i = blockIdx.x * 512 + tid; i < MTOK * 4; i += gridDim.x * 512) { const int t = i >> 2, h = i & 3; const float* r = sm + (size_t)t * 16;
          gb[t * 16 + h] = -__expf(a.in[6][h]) * softplusf_(r[8 + h] + a.in[8][h]);
          gb[t * 16 + 4 + h] = -__expf(a.in[7][h]) * softplusf_(r[12 + h] + a.in[9][h]);
          gb[t * 16 + 8 + h] = sigmoidf_(r[h]); gb[t * 16 + 12 + h] = sigmoidf_(r[4 + h]); } }
    const int gw = blockIdx.x * 8 + w, NGW = gridDim.x * 8;
    for (int it = gw; it < 512 * 16; it += NGW) {
        const int grp = it >> 4, sec = ((it & 15) + 4 * (it >> 11)) & 15, b = grp >> 8, s0 = (grp & 255) * 32;
        if (sec < 4) p2_head<0>(a, b, s0, sec, lane);
        else if (sec < 8) p2_head<1>(a, b, s0, sec - 4, lane);
        else if (sec < 12) p2_head<2>(a, b, s0, sec - 8, lane);
        else p2_mixa(a, b, s0, sec - 12, lane);
    }
}

constexpr int L_QS = 0, L_KS = 17408, L_KTS = 34816, L_VTS = 53248, L_AM = 71680, L_TW = 104448, L_TU = 122880, L_GS = 141312;
typedef short s16x4 __attribute__((ext_vector_type(4)));
DI unsigned p3_offb(unsigned row, unsigned ch) { return 256u * row + 16u * (ch ^ (((row & 3u) << 2) | ((row >> 2) & 3u))); }
DI bf16x8 p3_tr_frag(LAS unsigned char* img, int lane, int c, int ks) {
    const unsigned g = (unsigned)lane >> 4, q = ((unsigned)lane & 15u) >> 2, p = (unsigned)lane & 3u;
    const s16x4 r0 = __builtin_amdgcn_ds_read_tr16_b64_v4i16((LAS s16x4*)(img + p3_offb(32u * ks + 8u * g + q, 2u * c + (p >> 1)) + 8u * (p & 1u)));
    const s16x4 r1 = __builtin_amdgcn_ds_read_tr16_b64_v4i16((LAS s16x4*)(img + p3_offb(32u * ks + 8u * g + 4u + q, 2u * c + (p >> 1)) + 8u * (p & 1u)));
    return __builtin_shufflevector(r0, r1, 0, 1, 2, 3, 4, 5, 6, 7);
}
DI void phase3(const Args& a, LAS unsigned char* lds) {
    const bf16_t* QT = (const bf16_t*)a.out; const bf16_t* KT = QT + (size_t)MTOK * 512; const bf16_t* VT = KT + (size_t)MTOK * 512;
    const float* GB = (const float*)(a.ws + OFF_GB);
    unsigned char* OPS = a.ws + A_OPS;
    for (int task = blockIdx.x; task < 1024; task += gridDim.x) {
        const int tid = otid(a.wv), lane = tid & 63, w = tid >> 6, dir = w >> 2, wq = w & 3, m16 = lane & 15, kg = lane >> 4;
        const int bh = task >> 7, nc = task & 127, b = bh >> 2, h = bh & 3;
        const size_t tb = (size_t)b * SEQ + nc * 64;
#pragma unroll
        for (int e = 0; e < 2; ++e) {
            const int ch = tid + 512 * e, row = ch >> 4, c16 = ch & 15;
            const size_t g = (tb + row) * 512 + h * 128 + c16 * 8;
            const u32x4 q = *(const u32x4*)(QT + g); *(LAS u32x4*)(lds + L_QS + row * 272 + c16 * 16) = q;
            const u32x4 k = *(const u32x4*)(KT + g); *(LAS u32x4*)(lds + L_KS + row * 272 + c16 * 16) = k;
            const u32x4 v = *(const u32x4*)(VT + g);
            const int grp = c16 >> 2, kgs = c16 & 3;
            *(LAS u32x4*)(lds + L_VTS + p3_offb(row, c16)) = v;
            { u32x2 k0 = {k[0], k[1]}, k1 = {k[2], k[3]};
              *(LAS u32x2*)(lds + L_KTS + p3_offb(row, grp * 4 + (kgs >> 1)) + 8 * (kgs & 1)) = k0;
              *(LAS u32x2*)(lds + L_KTS + p3_offb(row, grp * 4 + 2 + (kgs >> 1)) + 8 * (kgs & 1)) = k1; }
        }
        if (w < 2) {
            const size_t tok = tb + (w ? 63 - lane : lane);
            float g = GB[tok * 16 + w * 4 + h]; const float bt = GB[tok * 16 + 8 + w * 4 + h];
#pragma unroll
            for (int o = 1; o < 64; o <<= 1) { const float t = __shfl_up(g, o); if (lane >= o) g += t; }
            LAS float* gs = (LAS float*)(lds + L_GS + w * 512);
            gs[lane] = g; gs[64 + lane] = bt;
        }
        __syncthreads();
        const LAS float* Gc = (const LAS float*)(lds + L_GS + dir * 512); const LAS float* Bt = Gc + 64;
        unsigned char* ops = OPS + (size_t)(task * 2 + dir) * OPS_TASK;
        {
            const int prow = dir ? 63 - (wq * 16 + m16) : wq * 16 + m16;
            bf16x8 Af[4], Qf[4];
#pragma unroll
            for (int kk = 0; kk < 4; ++kk) { Af[kk] = *(const LAS bf16x8*)(lds + L_KS + prow * 272 + (kk * 32 + kg * 8) * 2); Qf[kk] = *(const LAS bf16x8*)(lds + L_QS + prow * 272 + (kk * 32 + kg * 8) * 2); }
            LAS float* AM = (LAS float*)(lds + L_AM + dir * 16384);
            f32x4 tl[4];
#pragma unroll
            for (int t = 0; t < 4; ++t) {
                tl[t] = (f32x4){0.f, 0.f, 0.f, 0.f};
                if (t <= wq) {
                    const int trow = dir ? 63 - (t * 16 + m16) : t * 16 + m16;
                    bf16x8 Kf[4];
#pragma unroll
                    for (int kk = 0; kk < 4; ++kk) Kf[kk] = *(const LAS bf16x8*)(lds + L_KS + trow * 272 + (kk * 32 + kg * 8) * 2);
                    f32x4 akk = {0.f, 0.f, 0.f, 0.f}, akq = {0.f, 0.f, 0.f, 0.f};
#pragma unroll
                    for (int kk = 0; kk < 4; ++kk) { akk = MFMA16(Af[kk], Kf[kk], akk); akq = MFMA16(Kf[kk], Qf[kk], akq); }
                    const int jc = t * 16 + m16; const float gj = Gc[jc];
                    const int cq = wq * 16 + m16; const float gcq = Gc[cq];
#pragma unroll
                    for (int r = 0; r < 4; ++r) {
                        const int c = wq * 16 + kg * 4 + r;
                        AM[c * 64 + jc] = (c > jc) ? Bt[c] * akk[r] * __expf(fminf(Gc[c] - gj, 0.f)) : 0.f;
                        const int jj = t * 16 + kg * 4 + r;
                        tl[t][r] = (cq >= jj) ? akq[r] * __expf(fminf(gcq - Gc[jj], 0.f)) : 0.f;
                    }
                }
            }
#pragma unroll
            for (int kk = 0; kk < 2; ++kk) *(bf16x8*)(ops + 16384 + (wq * 2 + kk) * 1024 + lane * 16) = pack8(tl[2 * kk], tl[2 * kk + 1]);
        }
        __syncthreads();
        if (wq == dir) {
            const LAS float* AM = (const LAS float*)(lds + L_AM + dir * 16384);
            typedef float f32x64 __attribute__((ext_vector_type(64))); f32x64 x;
            int lane_o = lane; asm volatile("" : "+v"(lane_o));
            f32x4 av[16], an[8];
#pragma unroll
            for (int q = 0; q < 16; ++q) av[q] = (f32x4){0.f, 0.f, 0.f, 0.f};
#pragma unroll
            for (int q = 0; q < 8; ++q) an[q] = (f32x4){0.f, 0.f, 0.f, 0.f};
            av[0] = *(const LAS f32x4*)(AM + 64);
            x[0] = (lane_o == 0) ? 1.f : 0.f;
#pragma unroll
            for (int i = 1; i < 64; ++i) {
#pragma unroll
                for (int j4 = 8; j4 < (i + 3) / 4; ++j4) av[j4] = *(const LAS f32x4*)(AM + i * 64 + j4 * 4);
                if (i + 1 < 64) {
#pragma unroll
                    for (int j4 = 0; j4 < ((i + 4) / 4 < 8 ? (i + 4) / 4 : 8); ++j4) an[j4] = *(const LAS f32x4*)(AM + (i + 1) * 64 + j4 * 4);
                }
                float s0 = 0.f, s1 = 0.f;
#pragma unroll
                for (int j4 = 0; j4 < (i + 3) / 4; ++j4) {
                    if (j4 * 4 + 0 < i) s0 = fmaf(av[j4][0], x[j4 * 4 + 0], s0);
                    if (j4 * 4 + 1 < i) s1 = fmaf(av[j4][1], x[j4 * 4 + 1], s1);
                    if (j4 * 4 + 2 < i) s0 = fmaf(av[j4][2], x[j4 * 4 + 2], s0);
                    if (j4 * 4 + 3 < i) s1 = fmaf(av[j4][3], x[j4 * 4 + 3], s1);
                }
                float xi = ((lane_o == i) ? 1.f : 0.f) - (s0 + s1);
                asm volatile("" : "+v"(xi) :: "memory");
                x[i] = xi;
#pragma unroll
                for (int j4 = 0; j4 < 8; ++j4) av[j4] = an[j4];
            }
            const float bt = Bt[lane], fu = bt, fw = bt * __expf(Gc[lane]);
            const int cs = dir ? 63 - lane : lane;
            LAS unsigned short* tw = (LAS unsigned short*)(lds + L_TW + dir * 9216 + cs * 2);
            LAS unsigned short* tu = (LAS unsigned short*)(lds + L_TU + dir * 9216 + cs * 2);
#pragma unroll
            for (int i = 0; i < 64; ++i) { const unsigned pw = pk2(x[i] * fw, x[i] * fu); tw[i * 72] = (unsigned short)pw; tu[i * 72] = (unsigned short)(pw >> 16); }
        }
        __syncthreads();
        {
            bf16x8 KA[2][2], VB[2][2];
#pragma unroll
            for (int tt = 0; tt < 2; ++tt)
#pragma unroll
                for (int kk = 0; kk < 2; ++kk) {
                    KA[tt][kk] = p3_tr_frag(lds + L_KTS, lane, 2 * wq + tt, kk);
                    VB[tt][kk] = p3_tr_frag(lds + L_VTS, lane, 2 * wq + tt, kk);
                }
#pragma unroll
            for (int i = 0; i < 4; ++i) {
                bf16x8 TB[2], TA[2];
#pragma unroll
                for (int kk = 0; kk < 2; ++kk) {
                    TB[kk] = *(const LAS bf16x8*)(lds + L_TW + dir * 9216 + (i * 16 + m16) * 144 + (kk * 32 + kg * 8) * 2);
                    TA[kk] = *(const LAS bf16x8*)(lds + L_TU + dir * 9216 + (i * 16 + m16) * 144 + (kk * 32 + kg * 8) * 2);
                }
                f32x4 a0 = {0.f, 0.f, 0.f, 0.f}, a1 = a0, u0 = a0, u1 = a0;
#pragma unroll
                for (int kk = 0; kk < 2; ++kk) { a0 = MFMA16(KA[0][kk], TB[kk], a0); a1 = MFMA16(KA[1][kk], TB[kk], a1); u0 = MFMA16(TA[kk], VB[0][kk], u0); u1 = MFMA16(TA[kk], VB[1][kk], u1); }
                *(bf16x8*)(ops + (i * 4 + wq) * 1024 + lane * 16) = pack8(a0, a1);
                *(f32x4*)(ops + 24576 + ((2 * wq) * 4 + i) * 1024 + lane * 16) = u0;
                *(f32x4*)(ops + 24576 + ((2 * wq + 1) * 4 + i) * 1024 + lane * 16) = u1;
            }
            if (wq == 1) {
                float* sc = (float*)(ops + 57344);
                const float gl = Gc[63], gc = Gc[lane];
                sc[lane] = __expf(gc); sc[64 + lane] = __expf(gl - gc);
                if (lane == 0) sc[128] = __expf(gl);
            }
        }
        __syncthreads();
    }
}

constexpr int SB_BYTES = 62464;
constexpr int X_OFF = 2 * SB_BYTES;
DI void scan_task(const Args& a, LAS unsigned char* lds, int bh, int dir, int dvt) {
    const int tid = otid(a.wv), lane = tid & 63, w = __builtin_amdgcn_readfirstlane(tid >> 6), m16 = lane & 15, kg = lane >> 4;
    const int b = bh >> 2, h = bh & 3;
    if (w < 4) {
        const int j = w;
        bf16_t* OD = (bf16_t*)a.out + (size_t)MTOK * 512 * (1 + dir);
        f32x4 S0 = {0.f, 0.f, 0.f, 0.f}, S1 = S0;
        LAS unsigned char* XL = lds + X_OFF + lane * 16;
        *(LAS bf16x8*)(XL + j * 1024) = pack8(S0, S1);
        for (int n = 0; n < 128; ++n) {
            LDS_WAIT(); __builtin_amdgcn_s_barrier(); asm volatile("" ::: "memory");
            const LAS unsigned char* B = lds + (n & 1) * SB_BYTES;
            const LAS unsigned char* BL = B + lane * 16;
            bf16x8 Sb[4];
#pragma unroll
            for (int kk = 0; kk < 4; ++kk) Sb[kk] = *(const LAS bf16x8*)(XL + kk * 1024);
            const f32x4 eg = *(const LAS f32x4*)(B + 28672 + (j * 16 + kg * 4) * 4), el = *(const LAS f32x4*)(B + 28672 + 256 + (j * 16 + kg * 4) * 4);
            const float egl = *(const LAS float*)(B + 28672 + 512);
            f32x4 acc = {0.f, 0.f, 0.f, 0.f}, o = acc;
#pragma unroll
            for (int kk = 0; kk < 4; ++kk) { acc = MFMA16(*(const LAS bf16x8*)(BL + (j * 4 + kk) * 1024), Sb[kk], acc); o = MFMA16(*(const LAS bf16x8*)(BL + 29696 + (j * 4 + kk) * 1024), Sb[kk], o); }
            const f32x4 vn = *(const LAS f32x4*)(BL + 24576 + j * 1024) - acc;
            const f32x4 vs = vn * el;
            { u32x2 vb = {pk2(vn[0], vn[1]), pk2(vn[2], vn[3])};
              *(LAS u32x2*)(XL + 6144 + (j >> 1) * 1024 + (j & 1) * 8) = vb;
              u32x2 vd; int off;
              if (!dir) { vd = (u32x2){pk2(vs[0], vs[1]), pk2(vs[2], vs[3])}; off = (j & 1) * 8; }
              else { vd = (u32x2){pk2(vs[3], vs[2]), pk2(vs[1], vs[0])}; off = (1 - (j & 1)) * 8; }
              *(LAS u32x2*)(XL + 4096 + (j >> 1) * 1024 + off) = vd; }
            o = o * eg;
            LDS_WAIT(); __builtin_amdgcn_s_barrier(); asm volatile("" ::: "memory");
            const bf16x8 Vd0 = *(const LAS bf16x8*)(XL + 4096), Vd1 = *(const LAS bf16x8*)(XL + 5120), Vb0 = *(const LAS bf16x8*)(XL + 6144), Vb1 = *(const LAS bf16x8*)(XL + 7168);
            S0 = S0 * egl; S1 = S1 * egl;
            S0 = MFMA16(*(const LAS bf16x8*)(BL + 46080 + (4 * j) * 1024), Vd0, S0); S1 = MFMA16(*(const LAS bf16x8*)(BL + 46080 + (4 * j + 2) * 1024), Vd0, S1);
            S0 = MFMA16(*(const LAS bf16x8*)(BL + 46080 + (4 * j + 1) * 1024), Vd1, S0); S1 = MFMA16(*(const LAS bf16x8*)(BL + 46080 + (4 * j + 3) * 1024), Vd1, S1);
            o = MFMA16(*(const LAS bf16x8*)(BL + 16384 + (2 * j) * 1024), Vb0, o);
            o = MFMA16(*(const LAS bf16x8*)(BL + 16384 + (2 * j + 1) * 1024), Vb1, o);
            *(LAS bf16x8*)(XL + j * 1024) = pack8(S0, S1);
            const int nc = dir ? 127 - n : n;
            const size_t tokb = (size_t)b * SEQ + nc * 64;
#pragma unroll
            for (int r = 0; r < 4; ++r) { const int c = j * 16 + kg * 4 + r; const size_t tok = tokb + (dir ? 63 - c : c);
                OD[tok * 512 + h * 128 + dvt * 16 + m16] = (bf16_t)pk2(o[r], 0.f); }
        }
    } else {
        const int li = w - 4;
        const unsigned char* OPS = a.ws + A_OPS; const bf16_t* QT = (const bf16_t*)a.out; const bf16_t* KTT = (const bf16_t*)(a.ws + A_KTT);
        const int nc0 = dir ? 127 : 0;
        const unsigned char* ops0 = OPS + (size_t)((bh * 128 + nc0) * 2 + dir) * OPS_TASK;
        const long st_ops = dir ? -2L * OPS_TASK : 2L * OPS_TASK, st_q = dir ? -65536L : 65536L, st_k = dir ? -128L : 128L;
        const unsigned char* ptr[16]; long stride[16]; unsigned ldso[16];
#pragma unroll
        for (int k = 0; k < 16; ++k) {
            const int u = min(li + 4 * k, 60); ldso[k] = (unsigned)(u * 1024 + lane * 16);
            const unsigned char* p = ops0; long st = st_ops;
            if (u < 24) p = ops0 + u * 1024 + lane * 16;
            else if (u < 28) p = ops0 + 24576 + (dvt * 4 + (u - 24)) * 1024 + lane * 16;
            else if (u == 28) p = ops0 + 57344 + lane * 16;
            else if (u < 45) { const int f = u - 29, i = f >> 2, kk = f & 3, c = i * 16 + m16; const size_t tok = (size_t)b * SEQ + nc0 * 64 + (dir ? 63 - c : c);
                p = (const unsigned char*)(QT + tok * 512 + h * 128 + kk * 32 + kg * 8); st = st_q; }
            else { const int f = u - 45, t = f >> 1, kk = f & 1, dk = t * 16 + m16; const int pos = nc0 * 64 + (dir ? (1 - kk) * 32 + (3 - kg) * 8 : kk * 32 + kg * 8);
                p = (const unsigned char*)(KTT + ((size_t)(bh * 128 + dk) * SEQ + pos)); st = st_k; }
            ptr[k] = p; stride[k] = st;
        }
        u32x4 R0[16], R1[16];
#pragma unroll
        for (int k = 0; k < 16; ++k) { R0[k] = *(GAS const u32x4*)ptr[k]; ptr[k] += stride[k]; }
#pragma unroll
        for (int k = 0; k < 16; ++k) { R1[k] = *(GAS const u32x4*)ptr[k]; ptr[k] += stride[k]; }
        for (int n = 0; n < 128; n += 2) {
            const long adv0 = (n + 3 < 128) ? 1L : 0L, adv1 = (n + 4 < 128) ? 1L : 0L;
#pragma unroll
            for (int k = 0; k < 16; ++k) *(LAS u32x4*)(lds + ldso[k]) = R0[k];
#pragma unroll
            for (int k = 0; k < 16; ++k) { R0[k] = *(GAS const u32x4*)ptr[k]; ptr[k] += stride[k] * adv0; }
            LDS_WAIT(); __builtin_amdgcn_s_barrier(); __builtin_amdgcn_s_barrier();
#pragma unroll
            for (int k = 0; k < 16; ++k) *(LAS u32x4*)(lds + SB_BYTES + ldso[k]) = R1[k];
#pragma unroll
            for (int k = 0; k < 16; ++k) { R1[k] = *(GAS const u32x4*)ptr[k]; ptr[k] += stride[k] * adv1; }
            LDS_WAIT(); __builtin_amdgcn_s_barrier(); __builtin_amdgcn_s_barrier();
        }
    }
    __syncthreads();
}

typedef GAS unsigned long long gu64; typedef GAS unsigned gu32;
#define RLX_AGENT __ATOMIC_RELAXED, __HIP_MEMORY_SCOPE_AGENT
DI void spin_ge(gu32* word, unsigned want, unsigned& seen) {
    if (seen >= want) return;
    unsigned sp = 0, v;
    while ((v = (unsigned)__builtin_amdgcn_readfirstlane(__hip_atomic_load(word, RLX_AGENT))) < want) { __builtin_amdgcn_s_sleep(1); if (++sp > (1u << 22)) break; }
    seen = v;
    asm volatile("" ::: "memory");
}
constexpr int SCAN_NT = 1;
template <int NT>
DI void scan_A(const Args& a, LAS unsigned char* lds, int t, int bh, int dir, int dvt0) {
    constexpr int SA = 16384 + NT * 4096 + 1024 + 16384, O_U = 16384, O_SC = 16384 + NT * 4096, O_KF = O_SC + 1024, NU = 33 + 4 * NT, NK = (NU + 2) / 3;
    constexpr int XA = 2 * SA, X_VD = NT * 4096, X_VB = NT * 4096 + NT * 2048;
    const int tid = otid(a.wv), lane = tid & 63, w = __builtin_amdgcn_readfirstlane(tid >> 6), m16 = lane & 15, kg = lane >> 4;
    LAS unsigned char* XL = lds + XA + lane * 16;
    if (w < 4) {
        const int j = w;
        f32x4 S0[NT], S1[NT];
#pragma unroll
        for (int e = 0; e < NT; ++e) { S0[e] = (f32x4){0.f, 0.f, 0.f, 0.f}; S1[e] = S0[e]; *(LAS bf16x8*)(XL + e * 4096 + j * 1024) = pack8(S0[e], S1[e]); }
        for (int n = 0; n < 128; ++n) {
            LDS_WAIT(); __builtin_amdgcn_s_barrier(); asm volatile("" ::: "memory");
            const LAS unsigned char* B = lds + (n & 1) * SA;
            const LAS unsigned char* BL = B + lane * 16;
            const f32x4 el = *(const LAS f32x4*)(B + O_SC + 256 + (j * 16 + kg * 4) * 4);
            const float egl = *(const LAS float*)(B + O_SC + 512);
            bf16x8 Wf[4];
#pragma unroll
            for (int kk = 0; kk < 4; ++kk) Wf[kk] = *(const LAS bf16x8*)(BL + (j * 4 + kk) * 1024);
#pragma unroll
            for (int e = 0; e < NT; ++e) {
                f32x4 acc = {0.f, 0.f, 0.f, 0.f};
#pragma unroll
                for (int kk = 0; kk < 4; ++kk) acc = MFMA16(Wf[kk], *(const LAS bf16x8*)(XL + e * 4096 + kk * 1024), acc);
                const f32x4 vn = *(const LAS f32x4*)(BL + O_U + e * 4096 + j * 1024) - acc;
                const f32x4 vs = vn * el;
                u32x2 vb = {pk2(vn[0], vn[1]), pk2(vn[2], vn[3])};
                *(LAS u32x2*)(XL + X_VB + e * 2048 + (j >> 1) * 1024 + (j & 1) * 8) = vb;
                u32x2 vd; int off;
                if (!dir) { vd = (u32x2){pk2(vs[0], vs[1]), pk2(vs[2], vs[3])}; off = (j & 1) * 8; }
                else { vd = (u32x2){pk2(vs[3], vs[2]), pk2(vs[1], vs[0])}; off = (1 - (j & 1)) * 8; }
                *(LAS u32x2*)(XL + X_VD + e * 2048 + (j >> 1) * 1024 + off) = vd;
            }
            LDS_WAIT(); __builtin_amdgcn_s_barrier(); asm volatile("" ::: "memory");
            bf16x8 Kf[4];
#pragma unroll
            for (int q = 0; q < 4; ++q) Kf[q] = *(const LAS bf16x8*)(BL + O_KF + (4 * j + q) * 1024);
#pragma unroll
            for (int e = 0; e < NT; ++e) {
                const bf16x8 Vd0 = *(const LAS bf16x8*)(XL + X_VD + e * 2048), Vd1 = *(const LAS bf16x8*)(XL + X_VD + e * 2048 + 1024);
                f32x4 s0 = S0[e] * egl, s1 = S1[e] * egl;
                s0 = MFMA16(Kf[0], Vd0, s0); s1 = MFMA16(Kf[2], Vd0, s1);
                s0 = MFMA16(Kf[1], Vd1, s0); s1 = MFMA16(Kf[3], Vd1, s1);
                S0[e] = s0; S1[e] = s1;
                *(LAS bf16x8*)(XL + e * 4096 + j * 1024) = pack8(s0, s1);
            }
        }
    } else if (w < 7) {
        const int li = w - 4;
        const unsigned char* OPS = a.ws + A_OPS; const bf16_t* KTT = (const bf16_t*)(a.ws + A_KTT);
        const int nc0 = dir ? 127 : 0;
        const unsigned char* ops0 = OPS + (size_t)((bh * 128 + nc0) * 2 + dir) * OPS_TASK;
        const long st_ops = dir ? -2L * OPS_TASK : 2L * OPS_TASK, st_k = dir ? -128L : 128L;
        const unsigned char* ptr[NK]; long stride[NK]; unsigned ldso[NK];
#pragma unroll
        for (int k = 0; k < NK; ++k) {
            const int u = min(li + 3 * k, NU - 1); ldso[k] = (unsigned)(u * 1024 + lane * 16);
            const unsigned char* p = ops0; long st = st_ops;
            if (u < 16) p = ops0 + u * 1024 + lane * 16;
            else if (u < 16 + 4 * NT) p = ops0 + 24576 + (dvt0 * 4 + (u - 16)) * 1024 + lane * 16;
            else if (u == 16 + 4 * NT) p = ops0 + 57344 + lane * 16;
            else { const int f = u - (17 + 4 * NT), tt = f >> 1, kk = f & 1, dk = tt * 16 + m16; const int pos = nc0 * 64 + (dir ? (1 - kk) * 32 + (3 - kg) * 8 : kk * 32 + kg * 8);
                p = (const unsigned char*)(KTT + ((size_t)(bh * 128 + dk) * SEQ + pos)); st = st_k; }
            ptr[k] = p; stride[k] = st;
        }
        constexpr int DA = 3;
        u32x4 R[DA][NK];
#pragma unroll
        for (int d = 0; d < DA; ++d)
#pragma unroll
            for (int k = 0; k < NK; ++k) { R[d][k] = *(GAS const u32x4*)ptr[k]; ptr[k] += stride[k]; }
        int n = 0;
        for (; n + DA <= 128; n += DA) {
#pragma unroll
            for (int sidx = 0; sidx < DA; ++sidx) {
                const int m = n + sidx; const unsigned bo = (m & 1) ? (unsigned)SA : 0u; const long adv = (m + DA + 1 < 128) ? 1L : 0L;
#pragma unroll
                for (int k = 0; k < NK; ++k) *(LAS u32x4*)(lds + bo + ldso[k]) = R[sidx][k];
#pragma unroll
                for (int k = 0; k < NK; ++k) { R[sidx][k] = *(GAS const u32x4*)ptr[k]; ptr[k] += stride[k] * adv; }
                LDS_WAIT(); __builtin_amdgcn_s_barrier(); __builtin_amdgcn_s_barrier();
            }
        }
#pragma unroll
        for (int sidx = 0; sidx < 128 % DA; ++sidx) {
            const int m = n + sidx; const unsigned bo = (m & 1) ? (unsigned)SA : 0u;
#pragma unroll
            for (int k = 0; k < NK; ++k) *(LAS u32x4*)(lds + bo + ldso[k]) = R[sidx][k];
            LDS_WAIT(); __builtin_amdgcn_s_barrier(); __builtin_amdgcn_s_barrier();
        }
    } else {
        gu32* prod = (gu32*)(a.ws + OFF_FLG) + 16 * t; gu32* ack = (gu32*)(a.ws + OFF_FLG + 8192) + 16 * t;
        unsigned char* ring = a.ws + OFF_RING + (size_t)t * RING_R * (RING_SLOT * NT);
        const __amdgpu_buffer_rsrc_t rrs = __builtin_amdgcn_make_buffer_rsrc(ring, 0, RING_R * RING_SLOT * NT, 0x00020000);
        unsigned ack_seen = 0u;
        for (int n = 0; n < 128; ++n) {
            __builtin_amdgcn_s_barrier(); asm volatile("" ::: "memory");
            u32x4 pv[6 * NT];
#pragma unroll
            for (int e = 0; e < NT; ++e)
#pragma unroll
                for (int kk = 0; kk < 4; ++kk) pv[e * 6 + kk] = *(const LAS u32x4*)(XL + e * 4096 + kk * 1024);
            LDS_WAIT(); __builtin_amdgcn_s_barrier(); asm volatile("" ::: "memory");
#pragma unroll
            for (int e = 0; e < NT; ++e) { pv[e * 6 + 4] = *(const LAS u32x4*)(XL + X_VB + e * 2048); pv[e * 6 + 5] = *(const LAS u32x4*)(XL + X_VB + e * 2048 + 1024); }
            LDS_WAIT();
            if (n >= 2) { if (NT == 1) asm volatile("s_waitcnt vmcnt(6)" ::: "memory"); else asm volatile("s_waitcnt vmcnt(12)" ::: "memory");
                if (lane == 0) __hip_atomic_store(prod, (unsigned)(n - 1), RLX_AGENT); }
            if (n >= RING_R) spin_ge(ack, (unsigned)(n - RING_R + 1), ack_seen);
            const unsigned so = (unsigned)(n % RING_R) * (unsigned)(RING_SLOT * NT) + (unsigned)lane * 16u;
#pragma unroll
            for (int f = 0; f < 6 * NT; ++f) __builtin_amdgcn_raw_buffer_store_b128(pv[f], rrs, so + f * 1024, 0, 16);
        }
        asm volatile("s_waitcnt vmcnt(0)" ::: "memory"); if (lane == 0) __hip_atomic_store(prod, 128u, RLX_AGENT);
    }
    __syncthreads();
}
template <int NT>
DI void scan_B(const Args& a, LAS unsigned char* lds, int t, int bh, int dir, int dvt0) {
    constexpr int SBB = 25600 + NT * 6144, NF = 6 * NT;
    const int tid = otid(a.wv), lane = tid & 63, w = __builtin_amdgcn_readfirstlane(tid >> 6), m16 = lane & 15, kg = lane >> 4;
    const int b = bh >> 2, h = bh & 3;
    if (w < 4) {
        const int j = w;
        bf16_t* OD = (bf16_t*)a.out + (size_t)MTOK * 512 * (1 + dir);
        for (int n = 0; n < 128; ++n) {
            __builtin_amdgcn_s_barrier(); asm volatile("" ::: "memory");
            const LAS unsigned char* B = lds + (n & 1) * SBB;
            const LAS unsigned char* BL = B + lane * 16;
            const f32x4 eg = *(const LAS f32x4*)(B + 24576 + (j * 16 + kg * 4) * 4);
            bf16x8 Qf[4], If[2];
#pragma unroll
            for (int kk = 0; kk < 4; ++kk) Qf[kk] = *(const LAS bf16x8*)(BL + (j * 4 + kk) * 1024);
            If[0] = *(const LAS bf16x8*)(BL + 16384 + (2 * j) * 1024); If[1] = *(const LAS bf16x8*)(BL + 16384 + (2 * j + 1) * 1024);
            const int nc = dir ? 127 - n : n;
            const size_t tokb = (size_t)b * SEQ + nc * 64;
#pragma unroll
            for (int e = 0; e < NT; ++e) {
                f32x4 o = {0.f, 0.f, 0.f, 0.f};
#pragma unroll
                for (int kk = 0; kk < 4; ++kk) o = MFMA16(Qf[kk], *(const LAS bf16x8*)(BL + 25600 + (e * 6 + kk) * 1024), o);
                o = o * eg;
                o = MFMA16(If[0], *(const LAS bf16x8*)(BL + 25600 + (e * 6 + 4) * 1024), o);
                o = MFMA16(If[1], *(const LAS bf16x8*)(BL + 25600 + (e * 6 + 5) * 1024), o);
#pragma unroll
                for (int r = 0; r < 4; ++r) { const int c = j * 16 + kg * 4 + r; const size_t tok = tokb + (dir ? 63 - c : c);
                    OD[tok * 512 + h * 128 + (dvt0 + e) * 16 + m16] = (bf16_t)pk2(o[r], 0.f); }
            }
            LDS_WAIT();
        }
    } else if (w < 7) {
        const int li = w - 4;
        const unsigned char* OPS = a.ws + A_OPS; const bf16_t* QT = (const bf16_t*)a.out;
        const int nc0 = dir ? 127 : 0;
        const unsigned char* ops0 = OPS + (size_t)((bh * 128 + nc0) * 2 + dir) * OPS_TASK;
        const long st_ops = dir ? -2L * OPS_TASK : 2L * OPS_TASK, st_q = dir ? -65536L : 65536L;
        const unsigned char* ptr[9]; long stride[9]; unsigned ldso[9];
#pragma unroll
        for (int k = 0; k < 9; ++k) {
            const int u = min(li + 3 * k, 24); ldso[k] = (unsigned)(u * 1024 + lane * 16);
            const unsigned char* p = ops0; long st = st_ops;
            if (u < 16) { const int i = u >> 2, kk = u & 3, c = i * 16 + m16; const size_t tok = (size_t)b * SEQ + nc0 * 64 + (dir ? 63 - c : c);
                p = (const unsigned char*)(QT + tok * 512 + h * 128 + kk * 32 + kg * 8); st = st_q; }
            else if (u < 24) p = ops0 + 16384 + (u - 16) * 1024 + lane * 16;
            else p = ops0 + 57344 + lane * 16;
            ptr[k] = p; stride[k] = st;
        }
        constexpr int DB = 4;
        u32x4 R[DB][9];
#pragma unroll
        for (int d = 0; d < DB; ++d)
#pragma unroll
            for (int k = 0; k < 9; ++k) { R[d][k] = *(GAS const u32x4*)ptr[k]; ptr[k] += stride[k]; }
        for (int n = 0; n < 128; n += DB) {
#pragma unroll
            for (int sidx = 0; sidx < DB; ++sidx) {
                const int m = n + sidx; const unsigned bo = (m & 1) ? (unsigned)SBB : 0u; const long adv = (m + DB + 1 < 128) ? 1L : 0L;
#pragma unroll
                for (int k = 0; k < 9; ++k) *(LAS u32x4*)(lds + bo + ldso[k]) = R[sidx][k];
#pragma unroll
                for (int k = 0; k < 9; ++k) { R[sidx][k] = *(GAS const u32x4*)ptr[k]; ptr[k] += stride[k] * adv; }
                LDS_WAIT(); __builtin_amdgcn_s_barrier();
            }
        }
    } else {
        gu32* prod = (gu32*)(a.ws + OFF_FLG) + 16 * t; gu32* ack = (gu32*)(a.ws + OFF_FLG + 8192) + 16 * t;
        const unsigned char* ring = a.ws + OFF_RING + (size_t)t * RING_R * (RING_SLOT * NT);
        constexpr int DC = 2;
        const __amdgpu_buffer_rsrc_t rrs = __builtin_amdgcn_make_buffer_rsrc((unsigned char*)ring, 0, RING_R * RING_SLOT * NT, 0x00020000);
        u32x4 P[DC][NF];
        unsigned prod_seen = 0u;
#pragma unroll
        for (int d = 0; d < DC; ++d) { spin_ge(prod, (unsigned)(d + 1), prod_seen);
#pragma unroll
            for (int f = 0; f < NF; ++f) P[d][f] = __builtin_amdgcn_raw_buffer_load_b128(rrs, (unsigned)d * (unsigned)(RING_SLOT * NT) + f * 1024 + (unsigned)lane * 16u, 0, 16); }
        for (int n = 0; n < 128; n += DC) {
#pragma unroll
            for (int sidx = 0; sidx < DC; ++sidx) {
                const int m = n + sidx; const unsigned bo = (m & 1) ? (unsigned)SBB : 0u;
#pragma unroll
                for (int f = 0; f < NF; ++f) *(LAS u32x4*)(lds + bo + 25600 + f * 1024 + lane * 16) = P[sidx][f];
                if (lane == 0) __hip_atomic_store(ack, (unsigned)(m + 1), RLX_AGENT);
                if (m + DC < 128) { spin_ge(prod, (unsigned)(m + DC + 1), prod_seen);
                    const unsigned so = (unsigned)((m + DC) % RING_R) * (unsigned)(RING_SLOT * NT) + (unsigned)lane * 16u;
#pragma unroll
                    for (int f = 0; f < NF; ++f) P[sidx][f] = __builtin_amdgcn_raw_buffer_load_b128(rrs, so + f * 1024, 0, 16); }
                LDS_WAIT(); __builtin_amdgcn_s_barrier();
            }
        }
    }
    __syncthreads();
}
DI void phase4(const Args& a, LAS unsigned char* lds) {
    if (gridDim.x == 256) {
        constexpr int TPX = 16 / SCAN_NT;
        const int x = blockIdx.x & 7, sl = blockIdx.x >> 3;
        if (sl < 2 * TPX) {
            const int t = x * TPX + (sl % TPX), grp = t / (8 / SCAN_NT), dvt0 = (t % (8 / SCAN_NT)) * SCAN_NT;
            if (sl < TPX) scan_A<SCAN_NT>(a, lds, t, grp >> 1, grp & 1, dvt0); else scan_B<SCAN_NT>(a, lds, t, grp >> 1, grp & 1, dvt0);
        }
        return;
    }
    for (int t = 0; t < 128; ++t) {
        const int owner = ((t >> 4) + 8 * (t & 15)) % (int)gridDim.x;
        if (owner != (int)blockIdx.x) continue;
        const int grp = t >> 3;
        scan_task(a, lds, grp >> 1, grp & 1, t & 7);
    }
}

DI void phase5(const Args& a) {
    const int tid = otid(a.wv), lane = tid & 63, w = tid >> 6;
    { const f32x4* p4 = (const f32x4*)a.in[1]; u32x2* pb = (u32x2*)(a.ws + OFF_PB);
      for (size_t i = (size_t)blockIdx.x * 512 + tid; i < (size_t)MTOK * PLE / 4; i += (size_t)gridDim.x * 512) { const f32x4 v = p4[i]; u32x2 o = {pk2(v[0], v[1]), pk2(v[2], v[3])}; pb[i] = o; } }
    const bf16_t* OF = (const bf16_t*)a.out + (size_t)MTOK * 512; const bf16_t* OB = OF + (size_t)MTOK * 512;
    const bf16_t* zg = (const bf16_t*)(a.ws + A_ZG); bf16_t* ydn = (bf16_t*)(a.ws + A_YDN);
    const float* gdn = a.in[10];
    const f32x4 g0 = *(const f32x4*)(gdn + (lane & 15) * 8), g1 = *(const f32x4*)(gdn + (lane & 15) * 8 + 4);
    for (int row = blockIdx.x * 8 + w; row < MTOK; row += gridDim.x * 8) {
        const u32x4 f = *(const u32x4*)(OF + (size_t)row * 512 + lane * 8), bb = *(const u32x4*)(OB + (size_t)row * 512 + lane * 8), z = *(const u32x4*)(zg + (size_t)row * 2560 + lane * 8);
        float o[8]; float ss = 0.f;
#pragma unroll
        for (int e = 0; e < 4; ++e) { o[2 * e] = bf_lo(f[e]) + bf_lo(bb[e]); o[2 * e + 1] = bf_hi(f[e]) + bf_hi(bb[e]); ss += o[2 * e] * o[2 * e] + o[2 * e + 1] * o[2 * e + 1]; }
        ss += __shfl_xor(ss, 1); ss += __shfl_xor(ss, 2); ss += __shfl_xor(ss, 4); ss += __shfl_xor(ss, 8);
        const float rstd = rsqrtf(ss * (1.0f / 128.0f) + EPS);
        u32x4 out;
#pragma unroll
        for (int e = 0; e < 4; ++e) { const float ga = e < 2 ? g0[2 * e] : g1[2 * e - 4], gb2 = e < 2 ? g0[2 * e + 1] : g1[2 * e - 3];
            out[e] = pk2(o[2 * e] * rstd * ga * bf_lo(z[e]), o[2 * e + 1] * rstd * gb2 * bf_hi(z[e])); }
        *(u32x4*)(ydn + (size_t)row * 512 + lane * 8) = out;
    }
}
DI void phase12(const Args& a) {
    const int tid = otid(a.wv), lane = tid & 63, w = tid >> 6;
    const float* rss3 = (const float*)(a.ws + OFF_RSS) + 2 * MTOK; const float* gf = a.in[20];
    for (int row = blockIdx.x * 8 + w; row < MTOK; row += gridDim.x * 8) {
        const float rstd = rsqrtf(rss3[row] * (1.0f / 1024.0f) + EPS);
        f32x4* o = (f32x4*)(a.out + (size_t)row * 1024) + lane;
#pragma unroll
        for (int j = 0; j < 4; ++j) { const f32x4 g = *((const f32x4*)gf + lane + 64 * j); f32x4 v = o[64 * j]; v = v * rstd * g; o[64 * j] = v; }
    }
}

#define XB_TMO      128
#define XB_XCNT(j)  (256  + 64 * (j))
#define XB_XSUB(j)  (1280 + 64 * (j))
#define XB_XGEN(j)  (2304 + 64 * (j))
#define XB_TOP      3328
#define XB_TOPGEN   3392
#define XCD_BAR_WORDS 3456
#define XB_SPIN_CAP (1u << 22)
DI unsigned xb_ld(unsigned* p) { return __hip_atomic_load(p, __ATOMIC_RELAXED, __HIP_MEMORY_SCOPE_AGENT); }
DI unsigned xb_add(unsigned* p, unsigned v) { return __hip_atomic_fetch_add(p, v, __ATOMIC_RELAXED, __HIP_MEMORY_SCOPE_AGENT); }
DI unsigned xb_xcc_id() { return (unsigned)__builtin_amdgcn_s_getreg((3 << 11) | 20) & 0xFu; }
#define XB_SPIN(cond, bar) do { unsigned _sp = 0; while (cond) { __builtin_amdgcn_s_sleep(1); \
    if ((++_sp & 255u) == 0u) { if (xb_ld(&(bar)[XB_TMO])) break; if (_sp > XB_SPIN_CAP) { atomicAdd(&(bar)[XB_TMO], 1u); break; } } } } while (0)
struct XcdBarrier { unsigned* bar; unsigned x; volatile LAS unsigned* st; bool leader; };
DI XcdBarrier xcd_barrier_post(unsigned* bar, volatile LAS unsigned* st) {
    XcdBarrier b; b.bar = bar; b.x = xb_xcc_id(); b.st = st; b.leader = threadIdx.x == 0;
    if (threadIdx.x == 0) (void)xb_add(&bar[XB_XCNT(b.x)], 1u);
    return b;
}
DI void xcd_barrier_complete(unsigned* bar, unsigned x, unsigned& nloc, unsigned& nx) {
    const unsigned G = gridDim.x * gridDim.y * gridDim.z;
    unsigned sum, cnt, mine, sp = 0u;
    for (;;) {
        sum = 0u; cnt = 0u; mine = 0u;
#pragma unroll
        for (unsigned j = 0; j < 16; ++j) { const unsigned c = xb_ld(&bar[XB_XCNT(j)]); sum += c; cnt += (c > 0u) ? 1u : 0u; mine = (j == x) ? c : mine; }
        if (sum == G) break;
        __builtin_amdgcn_s_sleep(1);
        if ((++sp & 255u) == 0u) { if (xb_ld(&bar[XB_TMO])) break; if (sp > XB_SPIN_CAP) { atomicAdd(&bar[XB_TMO], 1u); break; } }
    }
    nloc = mine > 0u ? mine : 1u; nx = cnt > 0u ? cnt : 1u;
}
DI void xcd_barrier(const XcdBarrier& b) {
    asm volatile("s_waitcnt vmcnt(0)" ::: "memory");
    __syncthreads();
    if (b.leader) {
        unsigned* bar = b.bar;
        __builtin_amdgcn_s_waitcnt(0);
        unsigned nloc = b.st[0], nx = b.st[1];
        if (nloc == 0u) { xcd_barrier_complete(bar, b.x, nloc, nx); b.st[0] = nloc; b.st[1] = nx; }
        const unsigned old = xb_add(&bar[XB_XSUB(b.x)], 1u);
        const unsigned gen = old / nloc;
        if (old + 1u == (gen + 1u) * nloc) {
            __builtin_amdgcn_fence(__ATOMIC_RELEASE, "agent");
            asm volatile("s_waitcnt vmcnt(0)" ::: "memory");
            const unsigned og = xb_add(&bar[XB_TOP], 1u);
            const unsigned tg = og / nx;
            if (og + 1u == (tg + 1u) * nx) xb_add(&bar[XB_TOPGEN], 1u);
            else XB_SPIN(xb_ld(&bar[XB_TOPGEN]) == tg, bar);
            __builtin_amdgcn_fence(__ATOMIC_ACQUIRE, "agent");
            xb_add(&bar[XB_XGEN(b.x)], 1u);
            asm volatile("s_waitcnt vmcnt(0)" ::: "memory");
        } else {
            XB_SPIN(xb_ld(&bar[XB_XGEN(b.x)]) == gen, bar);
            __builtin_amdgcn_fence(__ATOMIC_ACQUIRE, "agent");
            asm volatile("s_waitcnt vmcnt(0)" ::: "memory");
        }
    }
    __syncthreads();
}

typedef const __attribute__((address_space(4))) Args* KArgP;
DI Args load_args() {
#if defined(__HIP_DEVICE_COMPILE__)
    KArgP p = (KArgP)__builtin_amdgcn_kernarg_segment_ptr(); asm volatile("" : "+s"(p));
    Args r;
#pragma unroll
    for (int i = 0; i < 21; ++i) r.in[i] = p->in[i];
    r.out = p->out; r.ws = p->ws; r.ph_lo = p->ph_lo; r.ph_hi = p->ph_hi; r.wv = 0; r.pad_ = 0; return r;
#else
    return Args{};
#endif
}
__global__ __launch_bounds__(512, 2) void fwd_mega(Args a_in) {
    extern __shared__ __attribute__((aligned(16))) unsigned char smem[];
    LAS unsigned char* lds = (LAS unsigned char*)smem;
    cg::grid_group grid = cg::this_grid();
    const int ph_lo = a_in.ph_lo, ph_hi = a_in.ph_hi;
    const int wv_s = __builtin_amdgcn_readfirstlane((int)(threadIdx.x >> 6));
    volatile LAS unsigned* xst = (volatile LAS unsigned*)(lds + LDS_BYTES - 16);
    if (threadIdx.x == 0) { xst[0] = 0u; xst[1] = 0u; }
    __syncthreads();
    (void)xcd_barrier_post((unsigned*)(a_in.ws + OFF_BAR), xst);
    if (ph_lo < 0) grid.sync();
#define GRID_BARRIER() do { XcdBarrier xb_; xb_.bar = (unsigned*)(load_args().ws + OFF_BAR); xb_.x = xb_xcc_id(); xb_.st = (volatile LAS unsigned*)(lds + LDS_BYTES - 16); xb_.leader = (wv_s == 0) && (olane() == 0); xcd_barrier(xb_); } while (0)
#define RUN_PHASE(PH, ...) do { if (ph_lo <= (PH) && (PH) < ph_hi) { for (int rep_ = 0; rep_ < ((PROBE_PH == (PH)) ? 2 : 1); ++rep_) { { Args a = load_args(); a.wv = wv_s; unsigned char* ws = a.ws; float* rss = (float*)(ws + OFF_RSS); \
        const int G = osg((int)gridDim.x), c = osg((int)blockIdx.x); (void)ws; (void)rss; (void)G; (void)c; __VA_ARGS__ } if ((PH) + 1 < ph_hi || rep_ == 0 && PROBE_PH == (PH)) GRID_BARRIER(); } } } while (0)
    RUN_PHASE(0, phase0(a, lds););
    RUN_PHASE(1, { pg8::StaticOrder S; S.init(MTOK, NPROJ, G, c); pg8::Gemm g{(const bf16_t*)(ws + A_XN), (const bf16_t*)(ws + A_XN), (const bf16_t*)(ws + OFF_WIN), (const bf16_t*)(ws + OFF_WIN), 1024, 16, 16, a.wv};
            EpiProj E{(bf16_t*)(ws + A_PROJA), (bf16_t*)(ws + A_ZG), (float*)(ws + OFF_SMALL)}; pg8::gemm_phase(lds, g, S, E);
            if (G == 256 && c >= 192) { __syncthreads(); p0_weights(a, lds, P0_I_IN, P0_NIT, c - 192, 64); } });
    RUN_PHASE(2, phase2(a););
    RUN_PHASE(3, phase3(a, lds););
    RUN_PHASE(4, phase4(a, lds););
    RUN_PHASE(5, phase5(a););
    RUN_PHASE(6, { pg8::StaticOrder S; S.init(MTOK, 1024, G, c); pg8::Gemm g{(const bf16_t*)a.out + (size_t)3 * MTOK * 512, (const bf16_t*)(ws + A_YDN), (const bf16_t*)(ws + OFF_WAD), (const bf16_t*)(ws + OFF_WAD) + (size_t)1024 * 512, 512, 16, 8, a.wv};
            EpiMerge E{(const bf16_t*)(ws + A_ZG), (bf16_t*)(ws + A_MERGED)}; pg8::gemm_phase(lds, g, S, E); });
    RUN_PHASE(7, { pg8::StaticOrder S; S.init(MTOK, 1024, G, c); pg8::Gemm g{(const bf16_t*)(ws + A_MERGED), (const bf16_t*)(ws + A_MERGED), (const bf16_t*)(ws + OFF_WO), (const bf16_t*)(ws + OFF_WO), 1024, 16, 16, a.wv};
            if (G == 256) { EpiResidDrain<false> E{a.in[0], (bf16_t*)(ws + A_H1B), rss}; pg8::gemm_phase(lds, g, S, E); } else { EpiResid<false> E{a.in[0], (bf16_t*)(ws + A_H1B), rss}; pg8::gemm_phase(lds, g, S, E); } });
    RUN_PHASE(8, { pg8::StaticOrder S; S.init(MTOK, DFF, G, c); pg8::Gemm g{(const bf16_t*)(ws + A_H1B), (const bf16_t*)(ws + A_H1B), (const bf16_t*)(ws + OFF_W1), (const bf16_t*)(ws + OFF_W1), 1024, 16, 16, a.wv};
            EpiFF1 E{rss, (bf16_t*)(ws + A_ACT)}; pg8::gemm_phase(lds, g, S, E); });
    RUN_PHASE(9, { pg8::StaticOrder S; S.init(MTOK, 1024, G, c); pg8::Gemm g{(const bf16_t*)(ws + A_ACT), (const bf16_t*)(ws + A_ACT), (const bf16_t*)(ws + OFF_W2), (const bf16_t*)(ws + OFF_W2), 4096, 64, 64, a.wv};
            if (G == 256) { EpiResidDrain<true> E{(const void*)(ws + A_H1B), (bf16_t*)(ws + A_H2B), rss + MTOK}; pg8::gemm_phase(lds, g, S, E); } else { EpiResid<true> E{(const void*)(ws + A_H1B), (bf16_t*)(ws + A_H2B), rss + MTOK}; pg8::gemm_phase(lds, g, S, E); } });
    if (ph_lo <= 10 && 10 < ph_hi) for (int rep_ = 0; rep_ < ((PROBE_PH == 10) ? 2 : 1); ++rep_) { Args a = load_args(); a.wv = wv_s; unsigned char* ws = a.ws; const int G = osg((int)gridDim.x), c = osg((int)blockIdx.x);
        pg8::StaticOrder S; S.init(MTOK, 1024, G, c); pg8::Gemm g{(const bf16_t*)(ws + OFF_PB), (const bf16_t*)(ws + OFF_PB), (const bf16_t*)(ws + OFF_WPP), (const bf16_t*)(ws + OFF_WPP), 256, 4, 4, a.wv};
        EpiPP E{(bf16_t*)(ws + A_PP)}; pg8::gemm_phase(lds, g, S, E);
    }
    if (gridDim.x == 256) {
        if (ph_lo <= 11 && 11 < ph_hi) { Args a = load_args(); a.wv = wv_s; unsigned char* ws = a.ws; float* rss = (float*)(ws + OFF_RSS); const int G = osg((int)gridDim.x), c = osg((int)blockIdx.x);
            pg8::StaticOrder S; S.init(MTOK, 1024, G, c); pg8::Gemm g{(const bf16_t*)(ws + A_H2B), (const bf16_t*)(ws + A_H2B), (const bf16_t*)(ws + OFF_WPG), (const bf16_t*)(ws + OFF_WPG), 1024, 16, 16, a.wv};
            EpiGateFinal E{rss + MTOK, (const bf16_t*)(ws + A_PP), (const bf16_t*)(ws + A_H2B), a.out, rss + 2 * MTOK, (unsigned*)(ws + OFF_CNT), a.in[20], a.wv}; pg8::gemm_phase(lds, g, S, E); }
    } else {
        RUN_PHASE(11, { pg8::StaticOrder S; S.init(MTOK, 1024, G, c); pg8::Gemm g{(const bf16_t*)(ws + A_H2B), (const bf16_t*)(ws + A_H2B), (const bf16_t*)(ws + OFF_WPG), (const bf16_t*)(ws + OFF_WPG), 1024, 16, 16, a.wv};
                EpiGate E{rss + MTOK, (const bf16_t*)(ws + A_PP), (const bf16_t*)(ws + A_H2B), a.out, rss + 2 * MTOK}; pg8::gemm_phase(lds, g, S, E); });
        RUN_PHASE(12, phase12(a););
    }
    for (int i = 0; i < PROBE_SYNCS; ++i) GRID_BARRIER();
}

extern "C" void kernel_launch(void* const* d_in, const int* in_sizes, int n_in, void* d_out, int out_size, void* d_ws, size_t ws_size, hipStream_t stream) {
    static int grid = 0;
    if (grid == 0) {
        if (n_in != 21 || out_size != MTOK * DM || ws_size < WS_NEED) { fprintf(stderr, "kernel_launch: unexpected shapes (n_in %d out %d ws %zu)\n", n_in, out_size, ws_size); grid = -1; return; }
        int dev = 0, cus = 0, per_cu = 0;
        (void)hipGetDevice(&dev);
        (void)hipDeviceGetAttribute(&cus, hipDeviceAttributeMultiprocessorCount, dev);
        if (hipFuncSetAttribute((const void*)fwd_mega, hipFuncAttributeMaxDynamicSharedMemorySize, LDS_BYTES) != hipSuccess) { fprintf(stderr, "kernel_launch: hipFuncSetAttribute failed\n"); grid = -1; return; }
        if (hipOccupancyMaxActiveBlocksPerMultiprocessor(&per_cu, (const void*)fwd_mega, 512, LDS_BYTES) != hipSuccess || per_cu < 1) per_cu = 1;
        (void)hipGetLastError();
        grid = cus * per_cu;
        if (grid > 256) grid = 256;
        grid &= ~7;
        if (grid < 8) grid = 8;
    }
    if (grid < 0) return;
    Args a{};
    for (int i = 0; i < 21; ++i) a.in[i] = (const float*)d_in[i];
    a.out = (float*)d_out; a.ws = (unsigned char*)d_ws;
    if (hipMemsetAsync((unsigned char*)d_ws + OFF_BAR, 0, XCD_BAR_WORDS * 4, stream) != hipSuccess) { fprintf(stderr, "kernel_launch: memset of the barrier words failed\n"); return; }
#if MK_PER_PHASE
    for (int ph = 0; ph < NPHASE; ++ph) { a.ph_lo = ph; a.ph_hi = ph + 1; hipLaunchKernelGGL(fwd_mega, dim3(grid), dim3(512), LDS_BYTES, stream, a); }
#else
    a.ph_lo = 0; a.ph_hi = NPHASE;
    void* args[] = {&a};
    hipError_t e = hipLaunchCooperativeKernel((const void*)fwd_mega, dim3(grid), dim3(512), args, LDS_BYTES, stream);
    if (e != hipSuccess) fprintf(stderr, "cooperative launch failed: %s (grid %d)\n", hipGetErrorString(e), grid);
#endif
}
```

```cpp
#include <hip/hip_runtime.h>
#include <hip/hip_cooperative_groups.h>
#include <cstdio>
#include <cstdint>
namespace cg = cooperative_groups;

#ifndef PROBE_PH
#define PROBE_PH -1
#endif
#ifndef PROBE_EXTRA
#define PROBE_EXTRA 0
#endif
#ifndef PROBE_SYNCS
#define PROBE_SYNCS 0
#endif
#ifndef MK_PER_PHASE
#define MK_PER_PHASE 0
#endif

#define DI __device__ __forceinline__
#define LAS __attribute__((address_space(3)))
#define GAS __attribute__((address_space(1)))
typedef unsigned short bf16_t;
typedef short bf16x8 __attribute__((ext_vector_type(8)));
typedef float f32x4 __attribute__((ext_vector_type(4)));
typedef float f32x2 __attribute__((ext_vector_type(2)));
typedef unsigned u32x4 __attribute__((ext_vector_type(4)));
typedef unsigned u32x2 __attribute__((ext_vector_type(2)));
typedef __bf16 bf16v2 __attribute__((ext_vector_type(2)));

constexpr int MTOK = 16384, DM = 1024, SEQ = 8192, NH = 4, DFF = 4096, PLE = 256;
constexpr float EPS = 1e-6f;
constexpr int NPROJ = 5888;
constexpr int LDS_BYTES = 147456;
constexpr int NPHASE = 13;

constexpr size_t OFF_RSS = 0;
constexpr size_t OFF_BAR = 196608;
constexpr size_t OFF_CNT = 212992;
constexpr size_t OFF_FLG = 221184;
constexpr size_t OFF_WIN = 262144;
constexpr size_t OFF_WAD = OFF_WIN + 12058624;
constexpr size_t OFF_WO = OFF_WAD + 2097152;
constexpr size_t OFF_W1 = OFF_WO + 2097152;
constexpr size_t OFF_W2 = OFF_W1 + 8388608;
constexpr size_t OFF_WPG = OFF_W2 + 8388608;
constexpr size_t OFF_WPP = OFF_WPG + 2097152;
constexpr size_t OFF_PB = OFF_WPP + 524288;
constexpr size_t OFF_SMALL = OFF_PB + 8388608;
constexpr size_t OFF_GB = OFF_SMALL + 1048576;
constexpr size_t ARENA = OFF_GB + 1048576;
constexpr size_t A_ZG = ARENA;
constexpr size_t A_XN = ARENA + 83886080;
constexpr size_t A_PROJA = ARENA + 117440512;
constexpr size_t A_KTT = A_XN;
constexpr size_t A_OPS = ARENA + 100663296;
constexpr size_t A_YDN = A_OPS;
constexpr size_t A_TMP = ARENA + 117440512;
constexpr size_t A_MERGED = ARENA + 184549376;
constexpr size_t A_H1B = ARENA;
constexpr size_t A_ACT = ARENA + 33554432;
constexpr size_t A_H2B = ARENA + 167772160;
constexpr size_t A_PP = ARENA;
constexpr size_t OFF_RING = OFF_PB;
constexpr int RING_R = 13, RING_SLOT = 6144;
constexpr size_t WS_NEED = 268435456;
constexpr int OPS_TASK = 58368;

struct Args {
    const float* in[21];
    float* out;
    unsigned char* ws;
    int ph_lo, ph_hi;
    int wv, pad_;
};

DI unsigned pk2(float a, float b) { f32x2 v = {a, b}; return __builtin_bit_cast(unsigned, __builtin_convertvector(v, bf16v2)); }
DI float bf_lo(unsigned u) { return __uint_as_float(u << 16); }
DI float bf_hi(unsigned u) { return __uint_as_float(u & 0xffff0000u); }
DI float wave_sum(float v) {
#pragma unroll
    for (int o = 1; o < 64; o <<= 1) v += __shfl_xor(v, o);
    return v;
}
DI float sigmoidf_(float v) { return __builtin_amdgcn_rcpf(1.0f + __expf(-v)); }
DI bf16x8 pack8(f32x4 a, f32x4 b) { u32x4 p = {pk2(a[0], a[1]), pk2(a[2], a[3]), pk2(b[0], b[1]), pk2(b[2], b[3])}; return __builtin_bit_cast(bf16x8, p); }
DI bf16x8 pack8r(f32x4 a, f32x4 b) { u32x4 p = {pk2(a[3], a[2]), pk2(a[1], a[0]), pk2(b[3], b[2]), pk2(b[1], b[0])}; return __builtin_bit_cast(bf16x8, p); }
#define MFMA16(a, b, c) __builtin_amdgcn_mfma_f32_16x16x32_bf16((a), (b), (c), 0, 0, 0)
#define LDS_WAIT() asm volatile("s_waitcnt lgkmcnt(0)" ::: "memory")
DI int olane() { int l = (int)__builtin_amdgcn_mbcnt_hi(~0u, __builtin_amdgcn_mbcnt_lo(~0u, 0u)); asm volatile("" : "+v"(l)); return l; }
DI int otid(int wv) { int t = wv * 64 + olane(); asm volatile("" : "+v"(t)); return t; }
DI int osg(int v) { asm volatile("" : "+s"(v)); return v; }

namespace pg8 {
constexpr int BM = 256, BK = 64, HALF = 128, HTB = HALF * BK * 2, STAGE_BYTES = 8 * HTB, NXCD = 8, WGM = 8;
DI int lds_byte(int r, int c) { const int st = (r >> 4) * 2 + (c >> 5), rr = r & 15, cc = c & 31, ob = rr * 64 + cc * 2; return st * 1024 + (ob ^ (((ob >> 9) & 1) << 5)); }
DI void stage_rc(int b, int& R, int& C) { const int st = b / 1024, sb = b % 1024, swz = sb ^ (((sb >> 9) & 1) << 5); R = (st >> 1) * 16 + swz / 64; C = (st & 1) * 32 + (swz % 64) / 2; }
DI int perm32(int rho) { const int n = rho >> 4, i = rho & 15; return 8 * (i >> 2) + 4 * n + (i & 3); }

struct Unit { int pm, pn; };
struct Gemm { const bf16_t* A; const bf16_t* A2; const bf16_t* Bt; const bf16_t* Bt2; int ld; int nt; int nth; int wv; };

struct StaticOrder {
    int nM, nN, nwg, G, c;
    DI void init(int M, int N, int G_, int c_) { nM = M / BM; nN = N / BM; nwg = nM * nN; G = G_; c = c_; }
    DI bool tile(long L, Unit& u) const {
        if (L >= nwg) return false;
        int wgid = (int)L; { const int q = nwg / NXCD, r = nwg % NXCD, xcd = wgid % NXCD, off = wgid / NXCD; wgid = (xcd < r ? xcd * (q + 1) : r * (q + 1) + (xcd - r) * q) + off; }
        const int nig = WGM * nN, gid = wgid / nig, fm = gid * WGM, gsz = (nM - fm) < WGM ? (nM - fm) : WGM;
        u.pm = fm + ((wgid % nig) % gsz); u.pn = (wgid % nig) / gsz; return true;
    }
    DI bool next(int i, Unit& u) const { return tile((long)i * G + c, u); }
};
template <class Epi, class Sched>
DI void gemm_phase(LAS unsigned char* lds, const Gemm g, const Sched& S, const Epi& E) {
    const int tid = otid(g.wv), wid = __builtin_amdgcn_readfirstlane(tid >> 6), lane = tid & 63, wr = wid >> 2, wc = wid & 3, fr = lane & 15, fq = lane >> 4;
    const int K = g.ld, nt = g.nt, nth = g.nth;
    unsigned voffA[2], voffB[2];
#pragma unroll
    for (int i = 0; i < 2; ++i) { int R, C; stage_rc(tid * 16 + i * 8192, R, C); const int Rb = (R & ~31) + perm32(R & 31);
        voffA[i] = (unsigned)(R * K + C) * 2u; voffB[i] = (unsigned)(Rb * K + C) * 2u; }
    const size_t kstep = (size_t)(BK * 2);
    const size_t hstep = (size_t)HALF * K * 2;
    const size_t tstep = 2 * hstep;
    const unsigned ldsw = (unsigned)wid * 1024u;
    const int aoff = lds_byte(wr * 64 + fr, fq * 8), boff = lds_byte(wc * 32 + fr, fq * 8);
#define PG8_SA(b, h) (((b) * 2 + (h)) * HTB)
#define PG8_SB(b, h) ((4 + (b) * 2 + (h)) * HTB)
#define PG8_STAGE(bufoff, gbase, voff) do { _Pragma("unroll") for (int _i = 0; _i < 2; ++_i) \
        __builtin_amdgcn_global_load_lds((const unsigned*)((const char*)(gbase) + (voff)[_i]), (LAS unsigned*)(lds + (bufoff) + ldsw + _i * 8192), 16, 0, 0); } while (0)
#define PG8_LDA(dst, b, h) do { _Pragma("unroll") for (int m = 0; m < 4; ++m) _Pragma("unroll") for (int k = 0; k < 2; ++k) dst[m][k] = *(const LAS bf16x8*)(lds + PG8_SA(b, h) + aoff + m * 2048 + k * 1024); } while (0)
#define PG8_LDB(dst, b, h) do { _Pragma("unroll") for (int n = 0; n < 2; ++n) _Pragma("unroll") for (int k = 0; k < 2; ++k) dst[n][k] = *(const LAS bf16x8*)(lds + PG8_SB(b, h) + boff + n * 2048 + k * 1024); } while (0)
#define PG8_MMA(ai, bj, At, Bt) do { __builtin_amdgcn_s_setprio(1); _Pragma("unroll") for (int m = 0; m < 4; ++m) _Pragma("unroll") for (int n = 0; n < 2; ++n) _Pragma("unroll") for (int k = 0; k < 2; ++k) \
        acc[ai][bj][m][n] = __builtin_amdgcn_mfma_f32_16x16x32_bf16(Bt[n][k], At[m][k], acc[ai][bj][m][n], 0, 0, 0); __builtin_amdgcn_s_setprio(0); } while (0)
#define PG8_WAIT_V(n) asm volatile("s_waitcnt vmcnt(" #n ")" ::: "memory")
#define PG8_WAIT_L(n) asm volatile("s_waitcnt lgkmcnt(" #n ")" ::: "memory")
#define PG8_BAR __builtin_amdgcn_s_barrier()
#define PG8_SCHED __builtin_amdgcn_sched_barrier(0)
    Unit cur, nxt; int ui = 0;
    if (!S.next(0, cur)) return;
    f32x4 acc[2][2][4][2];
#pragma unroll
    for (int a = 0; a < 2; ++a)
#pragma unroll
        for (int b = 0; b < 2; ++b)
#pragma unroll
            for (int m = 0; m < 4; ++m)
#pragma unroll
                for (int n = 0; n < 2; ++n) acc[a][b][m][n] = (f32x4){0.f, 0.f, 0.f, 0.f};
    bf16x8 At[4][2], B0[2][2], B1[2][2];
    const char* cA = (const char*)g.A + (size_t)cur.pm * tstep; const char* cB = (const char*)g.Bt + (size_t)cur.pn * tstep;
    const long dA2 = (const char*)g.A2 - (const char*)g.A - (long)nth * (long)kstep, dB2 = (const char*)g.Bt2 - (const char*)g.Bt - (long)nth * (long)kstep;
    PG8_STAGE(PG8_SB(0, 0), cB, voffB); PG8_STAGE(PG8_SA(0, 0), cA, voffA); PG8_STAGE(PG8_SB(0, 1), cB + hstep, voffB); PG8_STAGE(PG8_SA(0, 1), cA + hstep, voffA);
    if (wr == 1) PG8_BAR;
    PG8_WAIT_V(4); PG8_BAR;
    PG8_STAGE(PG8_SB(1, 0), cB + kstep, voffB); PG8_STAGE(PG8_SA(1, 0), cA + kstep, voffA); PG8_STAGE(PG8_SB(1, 1), cB + hstep + kstep, voffB);
    PG8_WAIT_V(6); PG8_BAR;
    for (;;) {
        const bool has_next = S.next(ui + 1, nxt);
        const char* nA = has_next ? (const char*)g.A + (size_t)nxt.pm * tstep : cA; const char* nB = has_next ? (const char*)g.Bt + (size_t)nxt.pn * tstep : cB;
        for (int t = 0; t < nt; t += 2) {
            const bool last = (t == nt - 2);
            if constexpr (Epi::HAS_MID) { if (t == nth) { const int l2 = olane(); E.mid(acc, cur, wr, wc, l2 & 15, l2 >> 4); PG8_SCHED; } }
            const char* a1 = cA + (size_t)(t + 1) * kstep + (t + 1 >= nth ? dA2 : 0L);
            const char* a2 = last ? nA : cA + (size_t)(t + 2) * kstep + (t + 2 >= nth ? dA2 : 0L); const char* b2 = last ? nB : cB + (size_t)(t + 2) * kstep + (t + 2 >= nth ? dB2 : 0L);
            const char* a3 = a2 + kstep; const char* b3 = b2 + kstep;
            PG8_LDB(B0, 0, 0); PG8_SCHED; PG8_LDA(At, 0, 0); PG8_STAGE(PG8_SA(1, 1), a1 + hstep, voffA);
            PG8_WAIT_L(8); PG8_BAR; PG8_WAIT_L(0); PG8_MMA(0, 0, At, B0); PG8_BAR; PG8_SCHED;
            PG8_LDB(B1, 0, 1); PG8_STAGE(PG8_SB(0, 0), b2, voffB);
            PG8_BAR; PG8_WAIT_L(0); PG8_MMA(0, 1, At, B1); PG8_BAR;
            PG8_LDA(At, 0, 1); PG8_STAGE(PG8_SA(0, 0), a2, voffA);
            PG8_BAR; PG8_WAIT_L(0); PG8_MMA(1, 0, At, B0); PG8_BAR; PG8_SCHED;
            PG8_STAGE(PG8_SB(0, 1), b2 + hstep, voffB);
            PG8_WAIT_V(6); PG8_BAR; PG8_MMA(1, 1, At, B1); PG8_BAR;
            PG8_LDB(B0, 1, 0); PG8_SCHED; PG8_LDA(At, 1, 0); PG8_STAGE(PG8_SA(0, 1), a2 + hstep, voffA);
            PG8_WAIT_L(8); PG8_BAR; PG8_WAIT_L(0); PG8_MMA(0, 0, At, B0); PG8_BAR; PG8_SCHED;
            PG8_LDB(B1, 1, 1); PG8_STAGE(PG8_SB(1, 0), b3, voffB);
            PG8_BAR; PG8_WAIT_L(0); PG8_MMA(0, 1, At, B1); PG8_BAR;
            PG8_LDA(At, 1, 1); PG8_STAGE(PG8_SA(1, 0), a3, voffA);
            PG8_BAR; PG8_WAIT_L(0); PG8_MMA(1, 0, At, B0); PG8_BAR; PG8_SCHED;
            PG8_STAGE(PG8_SB(1, 1), b3 + hstep, voffB);
            PG8_WAIT_V(6); PG8_BAR; PG8_MMA(1, 1, At, B1); PG8_BAR;
        }
        if constexpr (!Epi::AFTER_DRAIN) { const int l2 = olane(); E(acc, cur, wr, wc, l2 & 15, l2 >> 4); }
        if (!has_next) break;
#pragma unroll
        for (int a = 0; a < 2; ++a)
#pragma unroll
            for (int b = 0; b < 2; ++b)
#pragma unroll
                for (int m = 0; m < 4; ++m)
#pragma unroll
                    for (int n = 0; n < 2; ++n) acc[a][b][m][n] = (f32x4){0.f, 0.f, 0.f, 0.f};
        cur = nxt; cA = nA; cB = nB; ++ui;
    }
    PG8_WAIT_V(0);
    if (wr == 0) PG8_BAR;
    PG8_BAR;
    if constexpr (Epi::AFTER_DRAIN) { const int l2 = olane(); E.fused(acc, cur, wr, wc, l2 & 15, l2 >> 4, lds); }
#undef PG8_SA
#undef PG8_SB
#undef PG8_STAGE
#undef PG8_LDA
#undef PG8_LDB
#undef PG8_MMA
#undef PG8_WAIT_V
#undef PG8_WAIT_L
#undef PG8_BAR
#undef PG8_SCHED
}
}
using pg8::Unit;
typedef f32x4 AccT[2][2][4][2];

DI void rowss_add(float* rss, int row, float s, int fq) {
    s += __shfl_xor(s, 16); s += __shfl_xor(s, 32);
    if (fq == 0) atomicAdd(rss + row, s);
}

struct EpiProj {
    static constexpr bool HAS_MID = false;
    static constexpr bool AFTER_DRAIN = false;
    bf16_t* proja; bf16_t* zg; float* small;
    DI void operator()(const AccT& acc, const Unit& u, int wr, int wc, int fr, int fq) const {
        const int row0 = u.pm * 256 + wr * 64 + fr, pn = u.pn;
        if (pn == 22) {
            if (wc == 0 && fq < 2) {
#pragma unroll
                for (int ai = 0; ai < 2; ++ai)
#pragma unroll
                    for (int m = 0; m < 4; ++m) { float* d = small + (size_t)(row0 + ai * 128 + m * 16) * 16 + 8 * fq;
                        *(f32x4*)d = acc[ai][0][m][0]; *(f32x4*)(d + 4) = acc[ai][0][m][1]; }
            }
            return;
        }
        bf16_t* base; int ld, colt, act;
        if (pn < 12) { base = proja; ld = 3072; colt = pn * 256; act = 0; }
        else if (pn < 14) { base = zg; ld = 2560; colt = (pn - 12) * 256; act = 1; }
        else { base = zg; ld = 2560; colt = 512 + (pn - 14) * 256; act = 2; }
#pragma unroll
        for (int ai = 0; ai < 2; ++ai)
#pragma unroll
            for (int m = 0; m < 4; ++m) { bf16_t* rowp = base + (size_t)(row0 + ai * 128 + m * 16) * ld + colt + wc * 32 + 8 * fq;
#pragma unroll
                for (int bj = 0; bj < 2; ++bj) { f32x4 v0 = acc[ai][bj][m][0], v1 = acc[ai][bj][m][1];
                    if (act) {
#pragma unroll
                        for (int j = 0; j < 4; ++j) { const float s0 = sigmoidf_(v0[j]), s1 = sigmoidf_(v1[j]); v0[j] = act == 1 ? v0[j] * s0 : s0; v1[j] = act == 1 ? v1[j] * s1 : s1; } }
                    u32x4 w = {pk2(v0[0], v0[1]), pk2(v0[2], v0[3]), pk2(v1[0], v1[1]), pk2(v1[2], v1[3])};
                    *(u32x4*)(rowp + bj * 128) = w; } }
    }
};
struct EpiMerge {
    static constexpr bool HAS_MID = true;
    static constexpr bool AFTER_DRAIN = false;
    const bf16_t* zg; bf16_t* merged;
    DI void mid(AccT& acc, const Unit& u, int wr, int wc, int fr, int fq) const {
        const int row0 = u.pm * 256 + wr * 64 + fr, col0 = u.pn * 256 + wc * 32 + 8 * fq;
#pragma unroll
        for (int ai = 0; ai < 2; ++ai)
#pragma unroll
            for (int m = 0; m < 4; ++m) { const size_t row = row0 + ai * 128 + m * 16;
                asm volatile("" ::: "memory");
#pragma unroll
                for (int bj = 0; bj < 2; ++bj) { const int col = col0 + bj * 128;
                    const u32x4 ga = *(const u32x4*)(zg + row * 2560 + 512 + col), gd = *(const u32x4*)(zg + row * 2560 + 1536 + col);
#pragma unroll
                    for (int e = 0; e < 4; ++e) { const float r0 = bf_lo(ga[e]) * __builtin_amdgcn_rcpf(fmaxf(bf_lo(gd[e]), 1e-30f)), r1 = bf_hi(ga[e]) * __builtin_amdgcn_rcpf(fmaxf(bf_hi(gd[e]), 1e-30f));
                        acc[ai][bj][m][e >> 1][(e & 1) * 2] *= r0; acc[ai][bj][m][e >> 1][(e & 1) * 2 + 1] *= r1; } } }
    }
    DI void operator()(const AccT& acc, const Unit& u, int wr, int wc, int fr, int fq) const {
        const int row0 = u.pm * 256 + wr * 64 + fr, col0 = u.pn * 256 + wc * 32 + 8 * fq;
#pragma unroll
        for (int ai = 0; ai < 2; ++ai)
#pragma unroll
            for (int m = 0; m < 4; ++m) { const size_t row = row0 + ai * 128 + m * 16;
#pragma unroll
                for (int bj = 0; bj < 2; ++bj) { const int col = col0 + bj * 128;
                    const u32x4 gw = *(const u32x4*)(zg + row * 2560 + 1536 + col);
                    const f32x4 g0 = {fmaxf(bf_lo(gw[0]), 1e-30f), fmaxf(bf_hi(gw[0]), 1e-30f), fmaxf(bf_lo(gw[1]), 1e-30f), fmaxf(bf_hi(gw[1]), 1e-30f)}, g1 = {fmaxf(bf_lo(gw[2]), 1e-30f), fmaxf(bf_hi(gw[2]), 1e-30f), fmaxf(bf_lo(gw[3]), 1e-30f), fmaxf(bf_hi(gw[3]), 1e-30f)};
                    const f32x4 v0 = acc[ai][bj][m][0] * g0, v1 = acc[ai][bj][m][1] * g1;
                    u32x4 w = {pk2(v0[0], v0[1]), pk2(v0[2], v0[3]), pk2(v1[0], v1[1]), pk2(v1[2], v1[3])};
                    *(u32x4*)(merged + row * 1024 + col) = w; } }
    }
};
template <bool BASE_BF16>
struct EpiResid {
    static constexpr bool HAS_MID = false;
    static constexpr bool AFTER_DRAIN = false;
    const void* base; bf16_t* hb; float* rss;
    DI void operator()(const AccT& acc, const Unit& u, int wr, int wc, int fr, int fq) const {
        const int row0 = u.pm * 256 + wr * 64 + fr, col0 = u.pn * 256 + wc * 32 + 8 * fq;
#pragma unroll
        for (int ai = 0; ai < 2; ++ai)
#pragma unroll
            for (int m = 0; m < 4; ++m) { const size_t row = row0 + ai * 128 + m * 16; float ss = 0.f;
#pragma unroll
                for (int bj = 0; bj < 2; ++bj) { const size_t o = row * 1024 + col0 + bj * 128;
                    f32x4 b0, b1;
                    if (BASE_BF16) { const u32x4 bw = *(const u32x4*)((const bf16_t*)base + o); b0 = (f32x4){bf_lo(bw[0]), bf_hi(bw[0]), bf_lo(bw[1]), bf_hi(bw[1])}; b1 = (f32x4){bf_lo(bw[2]), bf_hi(bw[2]), bf_lo(bw[3]), bf_hi(bw[3])}; }
                    else { b0 = *(const f32x4*)((const float*)base + o); b1 = *(const f32x4*)((const float*)base + o + 4); }
                    const f32x4 v0 = b0 + acc[ai][bj][m][0], v1 = b1 + acc[ai][bj][m][1];
                    u32x4 w = {pk2(v0[0], v0[1]), pk2(v0[2], v0[3]), pk2(v1[0], v1[1]), pk2(v1[2], v1[3])};
                    *(u32x4*)(hb + o) = w;
#pragma unroll
                    for (int j = 0; j < 4; ++j) ss += v0[j] * v0[j] + v1[j] * v1[j]; }
                rowss_add(rss, (int)row, ss, fq); }
    }
};
template <bool BASE_BF16>
struct EpiResidDrain {
    static constexpr bool HAS_MID = false;
    static constexpr bool AFTER_DRAIN = true;
    const void* base; bf16_t* hb; float* rss;
    DI void operator()(const AccT&, const Unit&, int, int, int, int) const {}
    DI void fused(AccT& acc, const Unit& u, int wr, int wc, int fr, int fq, LAS unsigned char* lds) const {
        const int row0 = u.pm * 256 + wr * 64 + fr, col0 = u.pn * 256 + wc * 32 + 8 * fq;
        LAS float* PS = (LAS float*)lds;
#pragma unroll
        for (int ai = 0; ai < 2; ++ai)
#pragma unroll
            for (int m = 0; m < 4; ++m) { const size_t row = row0 + ai * 128 + m * 16; float ss = 0.f;
#pragma unroll
                for (int bj = 0; bj < 2; ++bj) { const size_t o = row * 1024 + col0 + bj * 128;
                    f32x4 b0, b1;
                    if (BASE_BF16) { const u32x4 bw = *(const u32x4*)((const bf16_t*)base + o); b0 = (f32x4){bf_lo(bw[0]), bf_hi(bw[0]), bf_lo(bw[1]), bf_hi(bw[1])}; b1 = (f32x4){bf_lo(bw[2]), bf_hi(bw[2]), bf_lo(bw[3]), bf_hi(bw[3])}; }
                    else { b0 = *(const f32x4*)((const float*)base + o); b1 = *(const f32x4*)((const float*)base + o + 4); }
                    const f32x4 v0 = b0 + acc[ai][bj][m][0], v1 = b1 + acc[ai][bj][m][1];
                    u32x4 w = {pk2(v0[0], v0[1]), pk2(v0[2], v0[3]), pk2(v1[0], v1[1]), pk2(v1[2], v1[3])};
                    *(u32x4*)(hb + o) = w;
#pragma unroll
                    for (int j = 0; j < 4; ++j) ss += v0[j] * v0[j] + v1[j] * v1[j]; }
                ss += __shfl_xor(ss, 16); ss += __shfl_xor(ss, 32);
                if (fq == 0) PS[(ai * 128 + wr * 64 + m * 16 + fr) * 4 + wc] = ss; }
        __syncthreads();
        const int t_ = (wr * 4 + wc) * 64 + fq * 16 + fr;
        if (t_ < 256) { const f32x4 p4 = *(const LAS f32x4*)(PS + t_ * 4); atomicAdd(rss + u.pm * 256 + t_, (p4[0] + p4[1]) + (p4[2] + p4[3])); }
    }
};
struct EpiFF1 {
    static constexpr bool HAS_MID = false;
    static constexpr bool AFTER_DRAIN = false;
    const float* rss; bf16_t* act;
    DI void operator()(const AccT& acc, const Unit& u, int wr, int wc, int fr, int fq) const {
        const int row0 = u.pm * 256 + wr * 64 + fr, col0 = u.pn * 256 + wc * 32 + 8 * fq;
#pragma unroll
        for (int ai = 0; ai < 2; ++ai)
#pragma unroll
            for (int m = 0; m < 4; ++m) { const size_t row = row0 + ai * 128 + m * 16; const float rstd = rsqrtf(rss[row] * (1.0f / 1024.0f) + EPS);
#pragma unroll
                for (int bj = 0; bj < 2; ++bj) { f32x4 v0 = acc[ai][bj][m][0] * rstd, v1 = acc[ai][bj][m][1] * rstd;
#pragma unroll
                    for (int j = 0; j < 4; ++j) { const float a0 = fmaxf(v0[j], 0.f), a1 = fmaxf(v1[j], 0.f); v0[j] = a0 * a0; v1[j] = a1 * a1; }
                    u32x4 w = {pk2(v0[0], v0[1]), pk2(v0[2], v0[3]), pk2(v1[0], v1[1]), pk2(v1[2], v1[3])};
                    *(u32x4*)(act + row * 4096 + col0 + bj * 128) = w; } }
    }
};
struct EpiPP {
    static constexpr bool HAS_MID = false;
    static constexpr bool AFTER_DRAIN = false;
    bf16_t* pp;
    DI void operator()(const AccT& acc, const Unit& u, int wr, int wc, int fr, int fq) const {
        const int row0 = u.pm * 256 + wr * 64 + fr, col0 = u.pn * 256 + wc * 32 + 8 * fq;
#pragma unroll
        for (int ai = 0; ai < 2; ++ai)
#pragma unroll
            for (int m = 0; m < 4; ++m) { const size_t row = row0 + ai * 128 + m * 16;
#pragma unroll
                for (int bj = 0; bj < 2; ++bj) { const f32x4 v0 = acc[ai][bj][m][0], v1 = acc[ai][bj][m][1];
                    u32x4 w = {pk2(v0[0], v0[1]), pk2(v0[2], v0[3]), pk2(v1[0], v1[1]), pk2(v1[2], v1[3])};
                    *(u32x4*)(pp + row * 1024 + col0 + bj * 128) = w; } }
    }
};
struct EpiGate {
    static constexpr bool HAS_MID = false;
    static constexpr bool AFTER_DRAIN = false;
    const float* rss2; const bf16_t* pp; const bf16_t* hin; float* h; float* rss3;
    DI void operator()(const AccT& acc, const Unit& u, int wr, int wc, int fr, int fq) const {
        const int row0 = u.pm * 256 + wr * 64 + fr, col0 = u.pn * 256 + wc * 32 + 8 * fq;
#pragma unroll
        for (int ai = 0; ai < 2; ++ai)
#pragma unroll
            for (int m = 0; m < 4; ++m) { const size_t row = row0 + ai * 128 + m * 16; const float rstd = rsqrtf(rss2[row] * (1.0f / 1024.0f) + EPS); float ss = 0.f;
#pragma unroll
                for (int bj = 0; bj < 2; ++bj) { const size_t o = row * 1024 + col0 + bj * 128;
                    const u32x4 pw = *(const u32x4*)(pp + o);
                    const f32x4 p0 = {bf_lo(pw[0]), bf_hi(pw[0]), bf_lo(pw[1]), bf_hi(pw[1])}, p1 = {bf_lo(pw[2]), bf_hi(pw[2]), bf_lo(pw[3]), bf_hi(pw[3])};
                    const u32x4 hw = *(const u32x4*)(hin + o);
                    f32x4 v0 = {bf_lo(hw[0]), bf_hi(hw[0]), bf_lo(hw[1]), bf_hi(hw[1])}, v1 = {bf_lo(hw[2]), bf_hi(hw[2]), bf_lo(hw[3]), bf_hi(hw[3])};
#pragma unroll
                    for (int j = 0; j < 4; ++j) { v0[j] += sigmoidf_(acc[ai][bj][m][0][j] * rstd) * p0[j]; v1[j] += sigmoidf_(acc[ai][bj][m][1][j] * rstd) * p1[j]; ss += v0[j] * v0[j] + v1[j] * v1[j]; }
                    *(f32x4*)(h + o) = v0; *(f32x4*)(h + o + 4) = v1; }
                rowss_add(rss3, (int)row, ss, fq); }
    }
};

struct EpiGateFinal {
    static constexpr bool HAS_MID = false;
    static constexpr bool AFTER_DRAIN = true;
    const float* rss2; const bf16_t* pp; const bf16_t* h; float* out; float* rss3; unsigned* cnt; const float* gfin; int wv;
    DI void operator()(const AccT&, const Unit&, int, int, int, int) const {}
    DI void fused(AccT& acc, const Unit& u, int wr, int wc, int fr, int fq, LAS unsigned char* lds) const {
        const int row0 = u.pm * 256 + wr * 64 + fr, col0 = u.pn * 256 + wc * 32 + 8 * fq;
        LAS float* PS = (LAS float*)lds;
#pragma unroll
        for (int ai = 0; ai < 2; ++ai)
#pragma unroll
            for (int m = 0; m < 4; ++m) { const size_t row = row0 + ai * 128 + m * 16; const float rstd = rsqrtf(rss2[row] * (1.0f / 1024.0f) + EPS); float ss = 0.f;
#pragma unroll
                for (int bj = 0; bj < 2; ++bj) { const size_t o = row * 1024 + col0 + bj * 128;
                    const u32x4 pw = *(const u32x4*)(pp + o);
                    const f32x4 p0 = {bf_lo(pw[0]), bf_hi(pw[0]), bf_lo(pw[1]), bf_hi(pw[1])}, p1 = {bf_lo(pw[2]), bf_hi(pw[2]), bf_lo(pw[3]), bf_hi(pw[3])};
                    const u32x4 hw = *(const u32x4*)(h + o);
                    f32x4 v0 = {bf_lo(hw[0]), bf_hi(hw[0]), bf_lo(hw[1]), bf_hi(hw[1])}, v1 = {bf_lo(hw[2]), bf_hi(hw[2]), bf_lo(hw[3]), bf_hi(hw[3])};
#pragma unroll
                    for (int j = 0; j < 4; ++j) { v0[j] += sigmoidf_(acc[ai][bj][m][0][j] * rstd) * p0[j]; v1[j] += sigmoidf_(acc[ai][bj][m][1][j] * rstd) * p1[j]; ss += v0[j] * v0[j] + v1[j] * v1[j]; }
                    acc[ai][bj][m][0] = v0; acc[ai][bj][m][1] = v1; }
                ss += __shfl_xor(ss, 16); ss += __shfl_xor(ss, 32);
                if (fq == 0) PS[(ai * 128 + wr * 64 + m * 16 + fr) * 4 + wc] = ss; }
        __syncthreads();
        { const int t_ = (wr * 4 + wc) * 64 + fq * 16 + fr;
          if (t_ < 256) { const f32x4 p4 = *(const LAS f32x4*)(PS + t_ * 4); atomicAdd(rss3 + u.pm * 256 + t_, (p4[0] + p4[1]) + (p4[2] + p4[3])); } }
        asm volatile("s_waitcnt vmcnt(0)" ::: "memory");
        __syncthreads();
        if (wv == 0 && olane() == 0) {
            __hip_atomic_fetch_add(cnt + 16 * u.pm, 1u, __ATOMIC_RELEASE, __HIP_MEMORY_SCOPE_AGENT);
            unsigned sp = 0;
            while (__hip_atomic_load(cnt + 16 * u.pm, __ATOMIC_RELAXED, __HIP_MEMORY_SCOPE_AGENT) < 4u) { __builtin_amdgcn_s_sleep(1); if (++sp > (1u << 22)) break; }
            __builtin_amdgcn_fence(__ATOMIC_ACQUIRE, "agent");
            asm volatile("s_waitcnt vmcnt(0)" ::: "memory");
        }
        __syncthreads();
#pragma unroll
        for (int ai = 0; ai < 2; ++ai)
#pragma unroll
            for (int m = 0; m < 4; ++m) { const size_t row = row0 + ai * 128 + m * 16;
                const float rstd3 = rsqrtf(__hip_atomic_load(rss3 + row, __ATOMIC_RELAXED, __HIP_MEMORY_SCOPE_AGENT) * (1.0f / 1024.0f) + EPS);
#pragma unroll
                for (int bj = 0; bj < 2; ++bj) { const size_t o = row * 1024 + col0 + bj * 128; const int col = col0 + bj * 128;
                    const f32x4 g0 = *(const f32x4*)(gfin + col), g1 = *(const f32x4*)(gfin + col + 4);
                    *(f32x4*)(out + o) = acc[ai][bj][m][0] * rstd3 * g0; *(f32x4*)(out + o + 4) = acc[ai][bj][m][1] * rstd3 * g1; } }
    }
};

DI int win_colmap(int j) { return j < 3584 ? j : (j < 5632 ? j + 16 : (j < 5648 ? j - 2048 : -1)); }
template <int MODE>
DI void tr_item(const float* W, int ldw, int K, bf16_t* WT, int row_off, const float* gain, LAS float* scr, int item, int nblk, int lane) {
    const int kb = item / nblk, nb = item % nblk, k0 = 64 * kb, n0 = 32 * nb;
    const int j = n0 + (lane & 31);
    const int src = MODE == 1 ? win_colmap(j) : j;
    float tv[32];
#pragma unroll
    for (int i = 0; i < 32; ++i) { const int kk = 2 * i + (lane >> 5); tv[i] = W[(size_t)(k0 + kk) * ldw + (src >= 0 ? src : 0)]; }
    if (gain) {
#pragma unroll
        for (int i = 0; i < 32; ++i) tv[i] *= gain[k0 + 2 * i + (lane >> 5)]; }
#pragma unroll
    for (int i = 0; i < 32; ++i) { const int kk = 2 * i + (lane >> 5); scr[kk * 33 + (lane & 31)] = src >= 0 ? tv[i] : 0.f; }
    LDS_WAIT();
    const int c = lane & 7;
#pragma unroll
    for (int jj = 0; jj < 4; ++jj) { const int n = (lane >> 3) + 8 * jj; const LAS float* s = scr + (8 * c) * 33 + n;
        u32x4 o = {pk2(s[0], s[33]), pk2(s[66], s[99]), pk2(s[132], s[165]), pk2(s[198], s[231])};
        *(u32x4*)(WT + (size_t)(row_off + n0 + n) * K + k0 + 8 * c) = o; }
    LDS_WAIT();
}
DI void p0_weights(const Args& a, LAS unsigned char* lds, int it0, int it1, int vc, int nvc) {
    const int tid = otid(a.wv), lane = tid & 63, w = tid >> 6;
    unsigned char* ws = a.ws;
    LAS float* scr = (LAS float*)(lds + w * 8704);
    constexpr int I_IN = 16 * 184, I_A = 8 * 32, I_O = 16 * 32, I_1 = 16 * 128, I_2 = 64 * 32;
    for (int it = it0 + vc * 8 + w; it < it1; it += nvc * 8) {
        int r = it;
        if (r < I_IN) { tr_item<1>(a.in[3], 5648, 1024, (bf16_t*)(ws + OFF_WIN), 0, nullptr, scr, r, 184, lane); continue; } r -= I_IN;
        if (r < I_A) { tr_item<0>(a.in[11], 1024, 512, (bf16_t*)(ws + OFF_WAD), 0, nullptr, scr, r, 32, lane); continue; } r -= I_A;
        if (r < I_A) { tr_item<0>(a.in[12], 1024, 512, (bf16_t*)(ws + OFF_WAD), 1024, nullptr, scr, r, 32, lane); continue; } r -= I_A;
        if (r < I_O) { tr_item<0>(a.in[13], 1024, 1024, (bf16_t*)(ws + OFF_WO), 0, nullptr, scr, r, 32, lane); continue; } r -= I_O;
        if (r < I_1) { tr_item<0>(a.in[15], 4096, 1024, (bf16_t*)(ws + OFF_W1), 0, a.in[14], scr, r, 128, lane); continue; } r -= I_1;
        if (r < I_2) { tr_item<0>(a.in[16], 1024, 4096, (bf16_t*)(ws + OFF_W2), 0, nullptr, scr, r, 32, lane); continue; } r -= I_2;
        if (r < I_O) { tr_item<0>(a.in[18], 1024, 1024, (bf16_t*)(ws + OFF_WPG), 0, a.in[17], scr, r, 32, lane); continue; } r -= I_O;
        tr_item<0>(a.in[19], 1024, 256, (bf16_t*)(ws + OFF_WPP), 0, nullptr, scr, r, 32, lane);
    }
}
constexpr int P0_I_IN = 16 * 184, P0_NIT = 16 * 184 + 2 * 8 * 32 + 16 * 32 + 16 * 128 + 64 * 32 + 16 * 32 + 4 * 32;
DI void phase0(const Args& a, LAS unsigned char* lds) {
    const int tid = otid(a.wv), lane = tid & 63, w = tid >> 6;
    const int gw = blockIdx.x * 8 + w, NGW = gridDim.x * 8;
    unsigned char* ws = a.ws;
    p0_weights(a, lds, 0, gridDim.x == 256 ? P0_I_IN : P0_NIT, blockIdx.x, gridDim.x);
    const float* x = a.in[0]; const float* gm = a.in[2]; bf16_t* xn = (bf16_t*)(ws + A_XN);
    for (int row0 = gw * 2; row0 < MTOK; row0 += NGW * 2) {
        f32x4 v[2][4]; float s[2] = {0.f, 0.f};
#pragma unroll
        for (int r = 0; r < 2; ++r) { const f32x4* xr = (const f32x4*)(x + (size_t)(row0 + r) * 1024) + lane;
#pragma unroll
            for (int j = 0; j < 4; ++j) v[r][j] = xr[64 * j]; }
#pragma unroll
        for (int r = 0; r < 2; ++r)
#pragma unroll
            for (int j = 0; j < 4; ++j) s[r] += (v[r][j][0] * v[r][j][0] + v[r][j][1] * v[r][j][1]) + (v[r][j][2] * v[r][j][2] + v[r][j][3] * v[r][j][3]);
#pragma unroll
        for (int o = 1; o < 64; o <<= 1) { s[0] += __shfl_xor(s[0], o); s[1] += __shfl_xor(s[1], o); }
#pragma unroll
        for (int r = 0; r < 2; ++r) { const float rstd = rsqrtf(s[r] * (1.0f / 1024.0f) + EPS);
            u32x2* o8 = (u32x2*)(xn + (size_t)(row0 + r) * 1024) + lane;
#pragma unroll
            for (int j = 0; j < 4; ++j) { const f32x4 g = *((const f32x4*)gm + lane + 64 * j);
                u32x2 o = {pk2(v[r][j][0] * rstd * g[0], v[r][j][1] * rstd * g[1]), pk2(v[r][j][2] * rstd * g[2], v[r][j][3] * rstd * g[3])}; o8[64 * j] = o; } }
    }
    { float* rss = (float*)(ws + OFF_RSS); for (int i = blockIdx.x * 512 + tid; i < 3 * MTOK; i += gridDim.x * 512) rss[i] = 0.f;
      unsigned* cnt = (unsigned*)(ws + OFF_CNT); for (int i = blockIdx.x * 512 + tid; i < 1024; i += gridDim.x * 512) cnt[i] = 0u;
      unsigned* flg = (unsigned*)(ws + OFF_FLG); for (int i = blockIdx.x * 512 + tid; i < 4096; i += gridDim.x * 512) flg[i] = 0u; }
}

DI float softplusf_(float x) { return fmaxf(x, 0.f) + log1pf(__expf(-fabsf(x))); }
DI float siluf_(float v) { return v * sigmoidf_(v); }
template <int KIND>
DI void p2_head(const Args& a, int b, int s0, int h, int lane) {
    const bf16_t* proja = (const bf16_t*)(a.ws + A_PROJA);
    bf16_t* QT = (bf16_t*)a.out; bf16_t* KT = QT + (size_t)MTOK * 512; bf16_t* VT = KT + (size_t)MTOK * 512; bf16_t* KTT = (bf16_t*)(a.ws + A_KTT);
    const int ch = KIND * 512 + h * 128 + 2 * lane;
    const float* cw = a.in[5];
    const float w00 = cw[ch], w01 = cw[ch + 1], w10 = cw[1536 + ch], w11 = cw[1536 + ch + 1], w20 = cw[3072 + ch], w21 = cw[3072 + ch + 1];
    const unsigned* src = (const unsigned*)(proja + (size_t)b * SEQ * 3072 + 1536 + ch);
    unsigned rw[34];
#pragma unroll
    for (int t = 0; t < 34; ++t) { const int s = s0 - 1 + t; rw[t] = (s >= 0 && s < SEQ) ? src[(size_t)s * 1536] : 0u; }
    float lo[32], hi[32], ss[32];
#pragma unroll
    for (int t = 0; t < 32; ++t) {
        lo[t] = siluf_(bf_lo(rw[t]) * w00 + bf_lo(rw[t + 1]) * w10 + bf_lo(rw[t + 2]) * w20);
        hi[t] = siluf_(bf_hi(rw[t]) * w01 + bf_hi(rw[t + 1]) * w11 + bf_hi(rw[t + 2]) * w21);
        ss[t] = lo[t] * lo[t] + hi[t] * hi[t];
    }
    if (KIND < 2) {
#pragma unroll
        for (int o = 1; o < 64; o <<= 1)
#pragma unroll
            for (int t = 0; t < 32; ++t) ss[t] += __shfl_xor(ss[t], o);
#pragma unroll
        for (int t = 0; t < 32; ++t) { const float rn = rsqrtf(ss[t] + EPS) * (KIND == 0 ? 0.08838834764831845f : 1.0f); lo[t] *= rn; hi[t] *= rn; }
    }
#pragma unroll
    for (int t = 0; t < 32; ++t) {
        const size_t tok = (size_t)b * SEQ + s0 + t;
        if (KIND == 2) { *(unsigned*)(VT + tok * 512 + h * 128 + 2 * lane) = pk2(lo[t], hi[t]); }
        else { const int d = 2 * lane, d32 = d & 31, pos = (d & ~31) + ((d32 >> 2) & 3) * 8 + (d32 >> 4) * 4 + (d32 & 3);
            *(unsigned*)((KIND == 0 ? QT : KT) + tok * 512 + h * 128 + pos) = pk2(lo[t], hi[t]); }
    }
    if (KIND == 1) {
        bf16_t* r0 = KTT + ((size_t)((b * 4 + h) * 128 + 2 * lane) * SEQ + s0);
        bf16_t* r1 = r0 + SEQ;
#pragma unroll
        for (int q4 = 0; q4 < 4; ++q4) { u32x4 o0, o1;
#pragma unroll
            for (int e = 0; e < 4; ++e) { const int p = q4 * 8 + e * 2, t0 = ((p & 7) >> 2) * 16 + (p >> 3) * 4 + (p & 3), t1 = t0 + 1;
                o0[e] = pk2(lo[t0], lo[t1]); o1[e] = pk2(hi[t0], hi[t1]); }
            *(u32x4*)(r0 + q4 * 8) = o0; *(u32x4*)(r1 + q4 * 8) = o1; }
    }
}
DI void p2_mixa(const Args& a, int b, int s0, int blk, int lane) {
    const bf16_t* proja = (const bf16_t*)(a.ws + A_PROJA);
    bf16_t* YA = (bf16_t*)a.out + (size_t)3 * MTOK * 512;
    const int c = blk * 128 + 2 * lane;
    const float* cw = a.in[4];
    const float w00 = cw[c], w01 = cw[c + 1], w10 = cw[512 + c], w11 = cw[512 + c + 1], w20 = cw[1024 + c], w21 = cw[1024 + c + 1];
    const unsigned* src = (const unsigned*)(proja + (size_t)b * SEQ * 3072 + c);
    float p0 = 0.f, p1 = 0.f, c0, c1;
    if (s0 > 0) { const unsigned bb = src[(size_t)(s0 - 1) * 1536], xx = src[(size_t)(s0 - 1) * 1536 + 512]; p0 = bf_lo(bb) * bf_lo(xx); p1 = bf_hi(bb) * bf_hi(xx); }
    { const unsigned bb = src[(size_t)s0 * 1536], xx = src[(size_t)s0 * 1536 + 512]; c0 = bf_lo(bb) * bf_lo(xx); c1 = bf_hi(bb) * bf_hi(xx); }
#pragma unroll 4
    for (int t = 0; t < 32; ++t) {
        const int s = s0 + t; float n0 = 0.f, n1 = 0.f;
        if (s + 1 < SEQ) { const unsigned bb = src[(size_t)(s + 1) * 1536], xx = src[(size_t)(s + 1) * 1536 + 512]; n0 = bf_lo(bb) * bf_lo(xx); n1 = bf_hi(bb) * bf_hi(xx); }
        const unsigned cc = src[(size_t)s * 1536 + 256];
        const float y0 = bf_lo(cc) * (p0 * w00 + c0 * w10 + n0 * w20), y1 = bf_hi(cc) * (p1 * w01 + c1 * w11 + n1 * w21);
        *(unsigned*)(YA + ((size_t)b * SEQ + s) * 512 + c) = pk2(y0, y1);
        p0 = c0; p1 = c1; c0 = n0; c1 = n1;
    }
}
DI void phase2(const Args& a) {
    const int tid = otid(a.wv), lane = tid & 63, w = tid >> 6;
    { const float* sm = (const float*)(a.ws + OFF_SMALL); float* gb = (float*)(a.ws + OFF_GB);
      for (int i = blockIdx.x * 512 + tid; i < MTOK * 4; i += gridDim.x * 512) { const int t = i >> 2, h = i & 3; const float* r = sm + (size_t)t * 16;
          gb[t * 16 + h] = -__expf(a.in[6][h]) * softplusf_(r[8 + h] + a.in[8][h]);
          gb[t * 16 + 4 + h] = -__expf(a.in[7][h]) * softplusf_(r[12 + h] + a.in[9][h]);
          gb[t * 16 + 8 + h] = sigmoidf_(r[h]); gb[t * 16 + 12 + h] = sigmoidf_(r[4 + h]); } }
    const int gw = blockIdx.x * 8 + w, NGW = gridDim.x * 8;
    for (int it = gw; it < 512 * 16; it += NGW) {
        const int grp = it >> 4, sec = ((it & 15) + 4 * (it >> 11)) & 15, b = grp >> 8, s0 = (grp & 255) * 32;
        if (sec < 4) p2_head<0>(a, b, s0, sec, lane);
        else if (sec < 8) p2_head<1>(a, b, s0, sec - 4, lane);
        else if (sec < 12) p2_head<2>(a, b, s0, sec - 8, lane);
        else p2_mixa(a, b, s0, sec - 12, lane);
    }
}

constexpr int L_QS = 0, L_KS = 17408, L_KTS = 34816, L_VTS = 53248, L_AM = 71680, L_TW = 104448, L_TU = 122880, L_GS = 141312;
typedef short s16x4 __attribute__((ext_vector_type(4)));
DI unsigned p3_offb(unsigned row, unsigned ch) { return 256u * row + 16u * (ch ^ (((row & 3u) << 2) | ((row >> 2) & 3u))); }
DI bf16x8 p3_tr_frag(LAS unsigned char* img, int lane, int c, int ks) {
    const unsigned g = (unsigned)lane >> 4, q = ((unsigned)lane & 15u) >> 2, p = (unsigned)lane & 3u;
    const s16x4 r0 = __builtin_amdgcn_ds_read_tr16_b64_v4i16((LAS s16x4*)(img + p3_offb(32u * ks + 8u * g + q, 2u * c + (p >> 1)) + 8u * (p & 1u)));
    const s16x4 r1 = __builtin_amdgcn_ds_read_tr16_b64_v4i16((LAS s16x4*)(img + p3_offb(32u * ks + 8u * g + 4u + q, 2u * c + (p >> 1)) + 8u * (p & 1u)));
    return __builtin_shufflevector(r0, r1, 0, 1, 2, 3, 4, 5, 6, 7);
}
DI void phase3(const Args& a, LAS unsigned char* lds) {
    const bf16_t* QT = (const bf16_t*)a.out; const bf16_t* KT = QT + (size_t)MTOK * 512; const bf16_t* VT = KT + (size_t)MTOK * 512;
    const float* GB = (const float*)(a.ws + OFF_GB);
    unsigned char* OPS = a.ws + A_OPS;
    for (int task = blockIdx.x; task < 1024; task += gridDim.x) {
        const int tid = otid(a.wv), lane = tid & 63, w = tid >> 6, dir = w >> 2, wq = w & 3, m16 = lane & 15, kg = lane >> 4;
        const int bh = task >> 7, nc = task & 127, b = bh >> 2, h = bh & 3;
        const size_t tb = (size_t)b * SEQ + nc * 64;
#pragma unroll
        for (int e = 0; e < 2; ++e) {
            const int ch = tid + 512 * e, row = ch >> 4, c16 = ch & 15;
            const size_t g = (tb + row) * 512 + h * 128 + c16 * 8;
            const u32x4 q = *(const u32x4*)(QT + g); *(LAS u32x4*)(lds + L_QS + row * 272 + c16 * 16) = q;
            const u32x4 k = *(const u32x4*)(KT + g); *(LAS u32x4*)(lds + L_KS + row * 272 + c16 * 16) = k;
            const u32x4 v = *(const u32x4*)(VT + g);
            const int grp = c16 >> 2, kgs = c16 & 3;
            *(LAS u32x4*)(lds + L_VTS + p3_offb(row, c16)) = v;
            { u32x2 k0 = {k[0], k[1]}, k1 = {k[2], k[3]};
              *(LAS u32x2*)(lds + L_KTS + p3_offb(row, grp * 4 + (kgs >> 1)) + 8 * (kgs & 1)) = k0;
              *(LAS u32x2*)(lds + L_KTS + p3_offb(row, grp * 4 + 2 + (kgs >> 1)) + 8 * (kgs & 1)) = k1; }
        }
        if (w < 2) {
            const size_t tok = tb + (w ? 63 - lane : lane);
            float g = GB[tok * 16 + w * 4 + h]; const float bt = GB[tok * 16 + 8 + w * 4 + h];
#pragma unroll
            for (int o = 1; o < 64; o <<= 1) { const float t = __shfl_up(g, o); if (lane >= o) g += t; }
            LAS float* gs = (LAS float*)(lds + L_GS + w * 512);
            gs[lane] = g; gs[64 + lane] = bt;
        }
        __syncthreads();
        const LAS float* Gc = (const LAS float*)(lds + L_GS + dir * 512); const LAS float* Bt = Gc + 64;
        unsigned char* ops = OPS + (size_t)(task * 2 + dir) * OPS_TASK;
        {
            const int prow = dir ? 63 - (wq * 16 + m16) : wq * 16 + m16;
            bf16x8 Af[4], Qf[4];
#pragma unroll
            for (int kk = 0; kk < 4; ++kk) { Af[kk] = *(const LAS bf16x8*)(lds + L_KS + prow * 272 + (kk * 32 + kg * 8) * 2); Qf[kk] = *(const LAS bf16x8*)(lds + L_QS + prow * 272 + (kk * 32 + kg * 8) * 2); }
            LAS float* AM = (LAS float*)(lds + L_AM + dir * 16384);
            f32x4 tl[4];
#pragma unroll
            for (int t = 0; t < 4; ++t) {
                tl[t] = (f32x4){0.f, 0.f, 0.f, 0.f};
                if (t <= wq) {
                    const int trow = dir ? 63 - (t * 16 + m16) : t * 16 + m16;
                    bf16x8 Kf[4];
#pragma unroll
                    for (int kk = 0; kk < 4; ++kk) Kf[kk] = *(const LAS bf16x8*)(lds + L_KS + trow * 272 + (kk * 32 + kg * 8) * 2);
                    f32x4 akk = {0.f, 0.f, 0.f, 0.f}, akq = {0.f, 0.f, 0.f, 0.f};
#pragma unroll
                    for (int kk = 0; kk < 4; ++kk) { akk = MFMA16(Af[kk], Kf[kk], akk); akq = MFMA16(Kf[kk], Qf[kk], akq); }
                    const int jc = t * 16 + m16; const float gj = Gc[jc];
                    const int cq = wq * 16 + m16; const float gcq = Gc[cq];
#pragma unroll
                    for (int r = 0; r < 4; ++r) {
                        const int c = wq * 16 + kg * 4 + r;
                        AM[c * 64 + jc] = (c > jc) ? Bt[c] * akk[r] * __expf(fminf(Gc[c] - gj, 0.f)) : 0.f;
                        const int jj = t * 16 + kg * 4 + r;
                        tl[t][r] = (cq >= jj) ? akq[r] * __expf(fminf(gcq - Gc[jj], 0.f)) : 0.f;
                    }
                }
            }
#pragma unroll
            for (int kk = 0; kk < 2; ++kk) *(bf16x8*)(ops + 16384 + (wq * 2 + kk) * 1024 + lane * 16) = pack8(tl[2 * kk], tl[2 * kk + 1]);
        }
        __syncthreads();
        if (wq == dir) {
            const LAS float* AM = (const LAS float*)(lds + L_AM + dir * 16384);
            typedef float f32x64 __attribute__((ext_vector_type(64))); f32x64 x;
            int lane_o = lane; asm volatile("" : "+v"(lane_o));
            f32x4 av[16], an[8];
#pragma unroll
            for (int q = 0; q < 16; ++q) av[q] = (f32x4){0.f, 0.f, 0.f, 0.f};
#pragma unroll
            for (int q = 0; q < 8; ++q) an[q] = (f32x4){0.f, 0.f, 0.f, 0.f};
            av[0] = *(const LAS f32x4*)(AM + 64);
            x[0] = (lane_o == 0) ? 1.f : 0.f;
#pragma unroll
            for (int i = 1; i < 64; ++i) {
#pragma unroll
                for (int j4 = 8; j4 < (i + 3) / 4; ++j4) av[j4] = *(const LAS f32x4*)(AM + i * 64 + j4 * 4);
                if (i + 1 < 64) {
#pragma unroll
                    for (int j4 = 0; j4 < ((i + 4) / 4 < 8 ? (i + 4) / 4 : 8); ++j4) an[j4] = *(const LAS f32x4*)(AM + (i + 1) * 64 + j4 * 4);
                }
                float s0 = 0.f, s1 = 0.f;
#pragma unroll
                for (int j4 = 0; j4 < (i + 3) / 4; ++j4) {
                    if (j4 * 4 + 0 < i) s0 = fmaf(av[j4][0], x[j4 * 4 + 0], s0);
                    if (j4 * 4 + 1 < i) s1 = fmaf(av[j4][1], x[j4 * 4 + 1], s1);
                    if (j4 * 4 + 2 < i) s0 = fmaf(av[j4][2], x[j4 * 4 + 2], s0);
                    if (j4 * 4 + 3 < i) s1 = fmaf(av[j4][3], x[j4 * 4 + 3], s1);
                }
                float xi = ((lane_o == i) ? 1.f : 0.f) - (s0 + s1);
                asm volatile("" : "+v"(xi) :: "memory");
                x[i] = xi;
#pragma unroll
                for (int j4 = 0; j4 < 8; ++j4) av[j4] = an[j4];
            }
            const float bt = Bt[lane], fu = bt, fw = bt * __expf(Gc[lane]);
            const int cs = dir ? 63 - lane : lane;
            LAS unsigned short* tw = (LAS unsigned short*)(lds + L_TW + dir * 9216 + cs * 2);
            LAS unsigned short* tu = (LAS unsigned short*)(lds + L_TU + dir * 9216 + cs * 2);
#pragma unroll
            for (int i = 0; i < 64; ++i) { const unsigned pw = pk2(x[i] * fw, x[i] * fu); tw[i * 72] = (unsigned short)pw; tu[i * 72] = (unsigned short)(pw >> 16); }
        }
        __syncthreads();
        {
            bf16x8 KA[2][2], VB[2][2];
#pragma unroll
            for (int tt = 0; tt < 2; ++tt)
#pragma unroll
                for (int kk = 0; kk < 2; ++kk) {
                    KA[tt][kk] = p3_tr_frag(lds + L_KTS, lane, 2 * wq + tt, kk);
                    VB[tt][kk] = p3_tr_frag(lds + L_VTS, lane, 2 * wq + tt, kk);
                }
#pragma unroll
            for (int i = 0; i < 4; ++i) {
                bf16x8 TB[2], TA[2];
#pragma unroll
                for (int kk = 0; kk < 2; ++kk) {
                    TB[kk] = *(const LAS bf16x8*)(lds + L_TW + dir * 9216 + (i * 16 + m16) * 144 + (kk * 32 + kg * 8) * 2);
                    TA[kk] = *(const LAS bf16x8*)(lds + L_TU + dir * 9216 + (i * 16 + m16) * 144 + (kk * 32 + kg * 8) * 2);
                }
                f32x4 a0 = {0.f, 0.f, 0.f, 0.f}, a1 = a0, u0 = a0, u1 = a0;
#pragma unroll
                for (int kk = 0; kk < 2; ++kk) { a0 = MFMA16(KA[0][kk], TB[kk], a0); a1 = MFMA16(KA[1][kk], TB[kk], a1); u0 = MFMA16(TA[kk], VB[0][kk], u0); u1 = MFMA16(TA[kk], VB[1][kk], u1); }
                *(bf16x8*)(ops + (i * 4 + wq) * 1024 + lane * 16) = pack8(a0, a1);
                *(f32x4*)(ops + 24576 + ((2 * wq) * 4 + i) * 1024 + lane * 16) = u0;
                *(f32x4*)(ops + 24576 + ((2 * wq + 1) * 4 + i) * 1024 + lane * 16) = u1;
            }
            if (wq == 1) {
                float* sc = (float*)(ops + 57344);
                const float gl = Gc[63], gc = Gc[lane];
                sc[lane] = __expf(gc); sc[64 + lane] = __expf(gl - gc);
                if (lane == 0) sc[128] = __expf(gl);
            }
        }
        __syncthreads();
    }
}

constexpr int SB_BYTES = 62464;
constexpr int X_OFF = 2 * SB_BYTES;
DI void scan_task(const Args& a, LAS unsigned char* lds, int bh, int dir, int dvt) {
    const int tid = otid(a.wv), lane = tid & 63, w = __builtin_amdgcn_readfirstlane(tid >> 6), m16 = lane & 15, kg = lane >> 4;
    const int b = bh >> 2, h = bh & 3;
    if (w < 4) {
        const int j = w;
        bf16_t* OD = (bf16_t*)a.out + (size_t)MTOK * 512 * (1 + dir);
        f32x4 S0 = {0.f, 0.f, 0.f, 0.f}, S1 = S0;
        LAS unsigned char* XL = lds + X_OFF + lane * 16;
        *(LAS bf16x8*)(XL + j * 1024) = pack8(S0, S1);
        for (int n = 0; n < 128; ++n) {
            LDS_WAIT(); __builtin_amdgcn_s_barrier(); asm volatile("" ::: "memory");
            const LAS unsigned char* B = lds + (n & 1) * SB_BYTES;
            const LAS unsigned char* BL = B + lane * 16;
            bf16x8 Sb[4];
#pragma unroll
            for (int kk = 0; kk < 4; ++kk) Sb[kk] = *(const LAS bf16x8*)(XL + kk * 1024);
            const f32x4 eg = *(const LAS f32x4*)(B + 28672 + (j * 16 + kg * 4) * 4), el = *(const LAS f32x4*)(B + 28672 + 256 + (j * 16 + kg * 4) * 4);
            const float egl = *(const LAS float*)(B + 28672 + 512);
            f32x4 acc = {0.f, 0.f, 0.f, 0.f}, o = acc;
#pragma unroll
            for (int kk = 0; kk < 4; ++kk) { acc = MFMA16(*(const LAS bf16x8*)(BL + (j * 4 + kk) * 1024), Sb[kk], acc); o = MFMA16(*(const LAS bf16x8*)(BL + 29696 + (j * 4 + kk) * 1024), Sb[kk], o); }
            const f32x4 vn = *(const LAS f32x4*)(BL + 24576 + j * 1024) - acc;
            const f32x4 vs = vn * el;
            { u32x2 vb = {pk2(vn[0], vn[1]), pk2(vn[2], vn[3])};
              *(LAS u32x2*)(XL + 6144 + (j >> 1) * 1024 + (j & 1) * 8) = vb;
              u32x2 vd; int off;
              if (!dir) { vd = (u32x2){pk2(vs[0], vs[1]), pk2(vs[2], vs[3])}; off = (j & 1) * 8; }
              else { vd = (u32x2){pk2(vs[3], vs[2]), pk2(vs[1], vs[0])}; off = (1 - (j & 1)) * 8; }
              *(LAS u32x2*)(XL + 4096 + (j >> 1) * 1024 + off) = vd; }
            o = o * eg;
            LDS_WAIT(); __builtin_amdgcn_s_barrier(); asm volatile("" ::: "memory");
            const bf16x8 Vd0 = *(const LAS bf16x8*)(XL + 4096), Vd1 = *(const LAS bf16x8*)(XL + 5120), Vb0 = *(const LAS bf16x8*)(XL + 6144), Vb1 = *(const LAS bf16x8*)(XL + 7168);
            S0 = S0 * egl; S1 = S1 * egl;
            S0 = MFMA16(*(const LAS bf16x8*)(BL + 46080 + (4 * j) * 1024), Vd0, S0); S1 = MFMA16(*(const LAS bf16x8*)(BL + 46080 + (4 * j + 2) * 1024), Vd0, S1);
            S0 = MFMA16(*(const LAS bf16x8*)(BL + 46080 + (4 * j + 1) * 1024), Vd1, S0); S1 = MFMA16(*(const LAS bf16x8*)(BL + 46080 + (4 * j + 3) * 1024), Vd1, S1);
            o = MFMA16(*(const LAS bf16x8*)(BL + 16384 + (2 * j) * 1024), Vb0, o);
            o = MFMA16(*(const LAS bf16x8*)(BL + 16384 + (2 * j + 1) * 1024), Vb1, o);
            *(LAS bf16x8*)(XL + j * 1024) = pack8(S0, S1);
            const int nc = dir ? 127 - n : n;
            const size_t tokb = (size_t)b * SEQ + nc * 64;
#pragma unroll
            for (int r = 0; r < 4; ++r) { const int c = j * 16 + kg * 4 + r; const size_t tok = tokb + (dir ? 63 - c : c);
                OD[tok * 512 + h * 128 + dvt * 16 + m16] = (bf16_t)pk2(o[r], 0.f); }
        }
    } else {
        const int li = w - 4;
        const unsigned char* OPS = a.ws + A_OPS; const bf16_t* QT = (const bf16_t*)a.out; const bf16_t* KTT = (const bf16_t*)(a.ws + A_KTT);
        const int nc0 = dir ? 127 : 0;
        const unsigned char* ops0 = OPS + (size_t)((bh * 128 + nc0) * 2 + dir) * OPS_TASK;
        const long st_ops = dir ? -2L * OPS_TASK : 2L * OPS_TASK, st_q = dir ? -65536L : 65536L, st_k = dir ? -128L : 128L;
        const unsigned char* ptr[16]; long stride[16]; unsigned ldso[16];
#pragma unroll
        for (int k = 0; k < 16; ++k) {
            const int u = min(li + 4 * k, 60); ldso[k] = (unsigned)(u * 1024 + lane * 16);
            const unsigned char* p = ops0; long st = st_ops;
            if (u < 24) p = ops0 + u * 1024 + lane * 16;
            else if (u < 28) p = ops0 + 24576 + (dvt * 4 + (u - 24)) * 1024 + lane * 16;
            else if (u == 28) p = ops0 + 57344 + lane * 16;
            else if (u < 45) { const int f = u - 29, i = f >> 2, kk = f & 3, c = i * 16 + m16; const size_t tok = (size_t)b * SEQ + nc0 * 64 + (dir ? 63 - c : c);
                p = (const unsigned char*)(QT + tok * 512 + h * 128 + kk * 32 + kg * 8); st = st_q; }
            else { const int f = u - 45, t = f >> 1, kk = f & 1, dk = t * 16 + m16; const int pos = nc0 * 64 + (dir ? (1 - kk) * 32 + (3 - kg) * 8 : kk * 32 + kg * 8);
                p = (const unsigned char*)(KTT + ((size_t)(bh * 128 + dk) * SEQ + pos)); st = st_k; }
            ptr[k] = p; stride[k] = st;
        }
        u32x4 R0[16], R1[16];
#pragma unroll
        for (int k = 0; k < 16; ++k) { R0[k] = *(GAS const u32x4*)ptr[k]; ptr[k] += stride[k]; }
#pragma unroll
        for (int k = 0; k < 16; ++k) { R1[k] = *(GAS const u32x4*)ptr[k]; ptr[k] += stride[k]; }
        for (int n = 0; n < 128; n += 2) {
            const long adv0 = (n + 3 < 128) ? 1L : 0L, adv1 = (n + 4 < 128) ? 1L : 0L;
#pragma unroll
            for (int k = 0; k < 16; ++k) *(LAS u32x4*)(lds + ldso[k]) = R0[k];
#pragma unroll
            for (int k = 0; k < 16; ++k) { R0[k] = *(GAS const u32x4*)ptr[k]; ptr[k] += stride[k] * adv0; }
            LDS_WAIT(); __builtin_amdgcn_s_barrier(); __builtin_amdgcn_s_barrier();
#pragma unroll
            for (int k = 0; k < 16; ++k) *(LAS u32x4*)(lds + SB_BYTES + ldso[k]) = R1[k];
#pragma unroll
            for (int k = 0; k < 16; ++k) { R1[k] = *(GAS const u32x4*)ptr[k]; ptr[k] += stride[k] * adv1; }
            LDS_WAIT(); __builtin_amdgcn_s_barrier(); __builtin_amdgcn_s_barrier();
        }
    }
    __syncthreads();
}

typedef GAS unsigned long long gu64; typedef GAS unsigned gu32;
#define RLX_AGENT __ATOMIC_RELAXED, __HIP_MEMORY_SCOPE_AGENT
DI void spin_ge(gu32* word, unsigned want, unsigned& seen) {
    if (seen >= want) return;
    unsigned sp = 0, v;
    while ((v = (unsigned)__builtin_amdgcn_readfirstlane(__hip_atomic_load(word, RLX_AGENT))) < want) { __builtin_amdgcn_s_sleep(1); if (++sp > (1u << 22)) break; }
    seen = v;
    asm volatile("" ::: "memory");
}
constexpr int SCAN_NT = 1;
template <int NT>
DI void scan_A(const Args& a, LAS unsigned char* lds, int t, int bh, int dir, int dvt0) {
    constexpr int SA = 16384 + NT * 4096 + 1024 + 16384, O_U = 16384, O_SC = 16384 + NT * 4096, O_KF = O_SC + 1024, NU = 33 + 4 * NT, NK = (NU + 2) / 3;
    constexpr int XA = 2 * SA, X_VD = NT * 4096, X_VB = NT * 4096 + NT * 2048;
    const int tid = otid(a.wv), lane = tid & 63, w = __builtin_amdgcn_readfirstlane(tid >> 6), m16 = lane & 15, kg = lane >> 4;
    LAS unsigned char* XL = lds + XA + lane * 16;
    if (w < 4) {
        const int j = w;
        f32x4 S0[NT], S1[NT];
#pragma unroll
        for (int e = 0; e < NT; ++e) { S0[e] = (f32x4){0.f, 0.f, 0.f, 0.f}; S1[e] = S0[e]; *(LAS bf16x8*)(XL + e * 4096 + j * 1024) = pack8(S0[e], S1[e]); }
        for (int n = 0; n < 128; ++n) {
            LDS_WAIT(); __builtin_amdgcn_s_barrier(); asm volatile("" ::: "memory");
            const LAS unsigned char* B = lds + (n & 1) * SA;
            const LAS unsigned char* BL = B + lane * 16;
            const f32x4 el = *(const LAS f32x4*)(B + O_SC + 256 + (j * 16 + kg * 4) * 4);
            const float egl = *(const LAS float*)(B + O_SC + 512);
            bf16x8 Wf[4];
#pragma unroll
            for (int kk = 0; kk < 4; ++kk) Wf[kk] = *(const LAS bf16x8*)(BL + (j * 4 + kk) * 1024);
#pragma unroll
            for (int e = 0; e < NT; ++e) {
                f32x4 acc = {0.f, 0.f, 0.f, 0.f};
#pragma unroll
                for (int kk = 0; kk < 4; ++kk) acc = MFMA16(Wf[kk], *(const LAS bf16x8*)(XL + e * 4096 + kk * 1024), acc);
                const f32x4 vn = *(const LAS f32x4*)(BL + O_U + e * 4096 + j * 1024) - acc;
                const f32x4 vs = vn * el;
                u32x2 vb = {pk2(vn[0], vn[1]), pk2(vn[2], vn[3])};
                *(LAS u32x2*)(XL + X_VB + e * 2048 + (j >> 1) * 1024 + (j & 1) * 8) = vb;
                u32x2 vd; int off;
                if (!dir) { vd = (u32x2){pk2(vs[0], vs[1]), pk2(vs[2], vs[3])}; off = (j & 1) * 8; }
                else { vd = (u32x2){pk2(vs[3], vs[2]), pk2(vs[1], vs[0])}; off = (1 - (j & 1)) * 8; }
                *(LAS u32x2*)(XL + X_VD + e * 2048 + (j >> 1) * 1024 + off) = vd;
            }
            LDS_WAIT(); __builtin_amdgcn_s_barrier(); asm volatile("" ::: "memory");
            bf16x8 Kf[4];
#pragma unroll
            for (int q = 0; q < 4; ++q) Kf[q] = *(const LAS bf16x8*)(BL + O_KF + (4 * j + q) * 1024);
#pragma unroll
            for (int e = 0; e < NT; ++e) {
                const bf16x8 Vd0 = *(const LAS bf16x8*)(XL + X_VD + e * 2048), Vd1 = *(const LAS bf16x8*)(XL + X_VD + e * 2048 + 1024);
                f32x4 s0 = S0[e] * egl, s1 = S1[e] * egl;
                s0 = MFMA16(Kf[0], Vd0, s0); s1 = MFMA16(Kf[2], Vd0, s1);
                s0 = MFMA16(Kf[1], Vd1, s0); s1 = MFMA16(Kf[3], Vd1, s1);
                S0[e] = s0; S1[e] = s1;
                *(LAS bf16x8*)(XL + e * 4096 + j * 1024) = pack8(s0, s1);
            }
        }
    } else if (w < 7) {
        const int li = w - 4;
        const unsigned char* OPS = a.ws + A_OPS; const bf16_t* KTT = (const bf16_t*)(a.ws + A_KTT);
        const int nc0 = dir ? 127 : 0;
        const unsigned char* ops0 = OPS + (size_t)((bh * 128 + nc0) * 2 + dir) * OPS_TASK;
        const long st_ops = dir ? -2L * OPS_TASK : 2L * OPS_TASK, st_k = dir ? -128L : 128L;
        const unsigned char* ptr[NK]; long stride[NK]; unsigned ldso[NK];
#pragma unroll
        for (int k = 0; k < NK; ++k) {
            const int u = min(li + 3 * k, NU - 1); ldso[k] = (unsigned)(u * 1024 + lane * 16);
            const unsigned char* p = ops0; long st = st_ops;
            if (u < 16) p = ops0 + u * 1024 + lane * 16;
            else if (u < 16 + 4 * NT) p = ops0 + 24576 + (dvt0 * 4 + (u - 16)) * 1024 + lane * 16;
            else if (u == 16 + 4 * NT) p = ops0 + 57344 + lane * 16;
            else { const int f = u - (17 + 4 * NT), tt = f >> 1, kk = f & 1, dk = tt * 16 + m16; const int pos = nc0 * 64 + (dir ? (1 - kk) * 32 + (3 - kg) * 8 : kk * 32 + kg * 8);
                p = (const unsigned char*)(KTT + ((size_t)(bh * 128 + dk) * SEQ + pos)); st = st_k; }
            ptr[k] = p; stride[k] = st;
        }
        constexpr int DA = 3;
        u32x4 R[DA][NK];
#pragma unroll
        for (int d = 0; d < DA; ++d)
#pragma unroll
            for (int k = 0; k < NK; ++k) { R[d][k] = *(GAS const u32x4*)ptr[k]; ptr[k] += stride[k]; }
        int n = 0;
        for (; n + DA <= 128; n += DA) {
#pragma unroll
            for (int sidx = 0; sidx < DA; ++sidx) {
                const int m = n + sidx; const unsigned bo = (m & 1) ? (unsigned)SA : 0u; const long adv = (m + DA + 1 < 128) ? 1L : 0L;
#pragma unroll
                for (int k = 0; k < NK; ++k) *(LAS u32x4*)(lds + bo + ldso[k]) = R[sidx][k];
#pragma unroll
                for (int k = 0; k < NK; ++k) { R[sidx][k] = *(GAS const u32x4*)ptr[k]; ptr[k] += stride[k] * adv; }
                LDS_WAIT(); __builtin_amdgcn_s_barrier(); __builtin_amdgcn_s_barrier();
            }
        }
#pragma unroll
        for (int sidx = 0; sidx < 128 % DA; ++sidx) {
            const int m = n + sidx; const unsigned bo = (m & 1) ? (unsigned)SA : 0u;
#pragma unroll
            for (int k = 0; k < NK; ++k) *(LAS u32x4*)(lds + bo + ldso[k]) = R[sidx][k];
            LDS_WAIT(); __builtin_amdgcn_s_barrier(); __builtin_amdgcn_s_barrier();
        }
    } else {
        gu32* prod = (gu32*)(a.ws + OFF_FLG) + 16 * t; gu32* ack = (gu32*)(a.ws + OFF_FLG + 8192) + 16 * t;
        unsigned char* ring = a.ws + OFF_RING + (size_t)t * RING_R * (RING_SLOT * NT);
        const __amdgpu_buffer_rsrc_t rrs = __builtin_amdgcn_make_buffer_rsrc(ring, 0, RING_R * RING_SLOT * NT, 0x00020000);
        unsigned ack_seen = 0u;
        for (int n = 0; n < 128; ++n) {
            __builtin_amdgcn_s_barrier(); asm volatile("" ::: "memory");
            u32x4 pv[6 * NT];
#pragma unroll
            for (int e = 0; e < NT; ++e)
#pragma unroll
                for (int kk = 0; kk < 4; ++kk) pv[e * 6 + kk] = *(const LAS u32x4*)(XL + e * 4096 + kk * 1024);
            LDS_WAIT(); __builtin_amdgcn_s_barrier(); asm volatile("" ::: "memory");
#pragma unroll
            for (int e = 0; e < NT; ++e) { pv[e * 6 + 4] = *(const LAS u32x4*)(XL + X_VB + e * 2048); pv[e * 6 + 5] = *(const LAS u32x4*)(XL + X_VB + e * 2048 + 1024); }
            LDS_WAIT();
            if (n >= 2) { if (NT == 1) asm volatile("s_waitcnt vmcnt(6)" ::: "memory"); else asm volatile("s_waitcnt vmcnt(12)" ::: "memory");
                if (lane == 0) __hip_atomic_store(prod, (unsigned)(n - 1), RLX_AGENT); }
            if (n >= RING_R) spin_ge(ack, (unsigned)(n - RING_R + 1), ack_seen);
            const unsigned so = (unsigned)(n % RING_R) * (unsigned)(RING_SLOT * NT) + (unsigned)lane * 16u;
#pragma unroll
            for (int f = 0; f < 6 * NT; ++f) __builtin_amdgcn_raw_buffer_store_b128(pv[f], rrs, so + f * 1024, 0, 16);
        }
        asm volatile("s_waitcnt vmcnt(0)" ::: "memory"); if (lane == 0) __hip_atomic_store(prod, 128u, RLX_AGENT);
    }
    __syncthreads();
}
template <int NT>
DI void scan_B(const Args& a, LAS unsigned char* lds, int t, int bh, int dir, int dvt0) {
    constexpr int SBB = 25600 + NT * 6144, NF = 6 * NT;
    const int tid = otid(a.wv), lane = tid & 63, w = __builtin_amdgcn_readfirstlane(tid >> 6), m16 = lane & 15, kg = lane >> 4;
    const int b = bh >> 2, h = bh & 3;
    if (w < 4) {
        const int j = w;
        bf16_t* OD = (bf16_t*)a.out + (size_t)MTOK * 512 * (1 + dir);
        for (int n = 0; n < 128; ++n) {
            __builtin_amdgcn_s_barrier(); asm volatile("" ::: "memory");
            const LAS unsigned char* B = lds + (n & 1) * SBB;
            const LAS unsigned char* BL = B + lane * 16;
            const f32x4 eg = *(const LAS f32x4*)(B + 24576 + (j * 16 + kg * 4) * 4);
            bf16x8 Qf[4], If[2];
#pragma unroll
            for (int kk = 0; kk < 4; ++kk) Qf[kk] = *(const LAS bf16x8*)(BL + (j * 4 + kk) * 1024);
            If[0] = *(const LAS bf16x8*)(BL + 16384 + (2 * j) * 1024); If[1] = *(const LAS bf16x8*)(BL + 16384 + (2 * j + 1) * 1024);
            const int nc = dir ? 127 - n : n;
            const size_t tokb = (size_t)b * SEQ + nc * 64;
#pragma unroll
            for (int e = 0; e < NT; ++e) {
                f32x4 o = {0.f, 0.f, 0.f, 0.f};
#pragma unroll
                for (int kk = 0; kk < 4; ++kk) o = MFMA16(Qf[kk], *(const LAS bf16x8*)(BL + 25600 + (e * 6 + kk) * 1024), o);
                o = o * eg;
                o = MFMA16(If[0], *(const LAS bf16x8*)(BL + 25600 + (e * 6 + 4) * 1024), o);
                o = MFMA16(If[1], *(const LAS bf16x8*)(BL + 25600 + (e * 6 + 5) * 1024), o);
#pragma unroll
                for (int r = 0; r < 4; ++r) { const int c = j * 16 + kg * 4 + r; const size_t tok = tokb + (dir ? 63 - c : c);
                    OD[tok * 512 + h * 128 + (dvt0 + e) * 16 + m16] = (bf16_t)pk2(o[r], 0.f); }
            }
            LDS_WAIT();
        }
    } else if (w < 7) {
        const int li = w - 4;
        const unsigned char* OPS = a.ws + A_OPS; const bf16_t* QT = (const bf16_t*)a.out;
        const int nc0 = dir ? 127 : 0;
        const unsigned char* ops0 = OPS + (size_t)((bh * 128 + nc0) * 2 + dir) * OPS_TASK;
        const long st_ops = dir ? -2L * OPS_TASK : 2L * OPS_TASK, st_q = dir ? -65536L : 65536L;
        const unsigned char* ptr[9]; long stride[9]; unsigned ldso[9];
#pragma unroll
        for (int k = 0; k < 9; ++k) {
            const int u = min(li + 3 * k, 24); ldso[k] = (unsigned)(u * 1024 + lane * 16);
            const unsigned char* p = ops0; long st = st_ops;
            if (u < 16) { const int i = u >> 2, kk = u & 3, c = i * 16 + m16; const size_t tok = (size_t)b * SEQ + nc0 * 64 + (dir ? 63 - c : c);
                p = (const unsigned char*)(QT + tok * 512 + h * 128 + kk * 32 + kg * 8); st = st_q; }
            else if (u < 24) p = ops0 + 16384 + (u - 16) * 1024 + lane * 16;
            else p = ops0 + 57344 + lane * 16;
            ptr[k] = p; stride[k] = st;
        }
        constexpr int DB = 4;
        u32x4 R[DB][9];
#pragma unroll
        for (int d = 0; d < DB; ++d)
#pragma unroll
            for (int k = 0; k < 9; ++k) { R[d][k] = *(GAS const u32x4*)ptr[k]; ptr[k] += stride[k]; }
        for (int n = 0; n < 128; n += DB) {
#pragma unroll
            for (int sidx = 0; sidx < DB; ++sidx) {
                const int m = n + sidx; const unsigned bo = (m & 1) ? (unsigned)SBB : 0u; const long adv = (m + DB + 1 < 128) ? 1L : 0L;
#pragma unroll
                for (int k = 0; k < 9; ++k) *(LAS u32x4*)(lds + bo + ldso[k]) = R[sidx][k];
#pragma unroll
                for (int k = 0; k < 9; ++k) { R[sidx][k] = *(GAS const u32x4*)ptr[k]; ptr[k] += stride[k] * adv; }
                LDS_WAIT(); __builtin_amdgcn_s_barrier();
            }
        }
    } else {
        gu32* prod = (gu32*)(a.ws + OFF_FLG) + 16 * t; gu32* ack = (gu32*)(a.ws + OFF_FLG + 8192) + 16 * t;
        const unsigned char* ring = a.ws + OFF_RING + (size_t)t * RING_R * (RING_SLOT * NT);
        constexpr int DC = 2;
        const __amdgpu_buffer_rsrc_t rrs = __builtin_amdgcn_make_buffer_rsrc((unsigned char*)ring, 0, RING_R * RING_SLOT * NT, 0x00020000);
        u32x4 P[DC][NF];
        unsigned prod_seen = 0u;
#pragma unroll
        for (int d = 0; d < DC; ++d) { spin_ge(prod, (unsigned)(d + 1), prod_seen);
#pragma unroll
            for (int f = 0; f < NF; ++f) P[d][f] = __builtin_amdgcn_raw_buffer_load_b128(rrs, (unsigned)d * (unsigned)(RING_SLOT * NT) + f * 1024 + (unsigned)lane * 16u, 0, 16); }
        for (int n = 0; n < 128; n += DC) {
#pragma unroll
            for (int sidx = 0; sidx < DC; ++sidx) {
                const int m = n + sidx; const unsigned bo = (m & 1) ? (unsigned)SBB : 0u;
#pragma unroll
                for (int f = 0; f < NF; ++f) *(LAS u32x4*)(lds + bo + 25600 + f * 1024 + lane * 16) = P[sidx][f];
                if (lane == 0) __hip_atomic_store(ack, (unsigned)(m + 1), RLX_AGENT);
                if (m + DC < 128) { spin_ge(prod, (unsigned)(m + DC + 1), prod_seen);
                    const unsigned so = (unsigned)((m + DC) % RING_R) * (unsigned)(RING_SLOT * NT) + (unsigned)lane * 16u;
#pragma unroll
                    for (int f = 0; f < NF; ++f) P[sidx][f] = __builtin_amdgcn_raw_buffer_load_b128(rrs, so + f * 1024, 0, 16); }
                LDS_WAIT(); __builtin_amdgcn_s_barrier();
            }
        }
    }
    __syncthreads();
}
DI void phase4(const Args& a, LAS unsigned char* lds) {
    if (gridDim.x == 256) {
        constexpr int TPX = 16 / SCAN_NT;
        const int x = blockIdx.x & 7, sl = blockIdx.x >> 3;
        if (sl < 2 * TPX) {
            const int t = x * TPX + (sl % TPX), grp = t / (8 / SCAN_NT), dvt0 = (t % (8 / SCAN_NT)) * SCAN_NT;
            if (sl < TPX) scan_A<SCAN_NT>(a, lds, t, grp >> 1, grp & 1, dvt0); else scan_B<SCAN_NT>(a, lds, t, grp >> 1, grp & 1, dvt0);
        }
        return;
    }
    for (int t = 0; t < 128; ++t) {
        const int owner = ((t >> 4) + 8 * (t & 15)) % (int)gridDim.x;
        if (owner != (int)blockIdx.x) continue;
        const int grp = t >> 3;
        scan_task(a, lds, grp >> 1, grp & 1, t & 7);
    }
}

DI void phase5(const Args& a) {
    const int tid = otid(a.wv), lane = tid & 63, w = tid >> 6;
    { const f32x4* p4 = (const f32x4*)a.in[1]; u32x2* pb = (u32x2*)(a.ws + OFF_PB);
      for (size_t i = (size_t)blockIdx.x * 512 + tid; i < (size_t)MTOK * PLE / 4; i += (size_t)gridDim.x * 512) { const f32x4 v = p4[i]; u32x2 o = {pk2(v[0], v[1]), pk2(v[2], v[3])}; pb[i] = o; } }
    const bf16_t* OF = (const bf16_t*)a.out + (size_t)MTOK * 512; const bf16_t* OB = OF + (size_t)MTOK * 512;
    const bf16_t* zg = (const bf16_t*)(a.ws + A_ZG); bf16_t* ydn = (bf16_t*)(a.ws + A_YDN);
    const float* gdn = a.in[10];
    const f32x4 g0 = *(const f32x4*)(gdn + (lane & 15) * 8), g1 = *(const f32x4*)(gdn + (lane & 15) * 8 + 4);
    for (int row = blockIdx.x * 8 + w; row < MTOK; row += gridDim.x * 8) {
        const u32x4 f = *(const u32x4*)(OF + (size_t)row * 512 + lane * 8), bb = *(const u32x4*)(OB + (size_t)row * 512 + lane * 8), z = *(const u32x4*)(zg + (size_t)row * 2560 + lane * 8);
        float o[8]; float ss = 0.f;
#pragma unroll
        for (int e = 0; e < 4; ++e) { o[2 * e] = bf_lo(f[e]) + bf_lo(bb[e]); o[2 * e + 1] = bf_hi(f[e]) + bf_hi(bb[e]); ss += o[2 * e] * o[2 * e] + o[2 * e + 1] * o[2 * e + 1]; }
        ss += __shfl_xor(ss, 1); ss += __shfl_xor(ss, 2); ss += __shfl_xor(ss, 4); ss += __shfl_xor(ss, 8);
        const float rstd = rsqrtf(ss * (1.0f / 128.0f) + EPS);
        u32x4 out;
#pragma unroll
        for (int e = 0; e < 4; ++e) { const float ga = e < 2 ? g0[2 * e] : g1[2 * e - 4], gb2 = e < 2 ? g0[2 * e + 1] : g1[2 * e - 3];
            out[e] = pk2(o[2 * e] * rstd * ga * bf_lo(z[e]), o[2 * e + 1] * rstd * gb2 * bf_hi(z[e])); }
        *(u32x4*)(ydn + (size_t)row * 512 + lane * 8) = out;
    }
}
DI void phase12(const Args& a) {
    const int tid = otid(a.wv), lane = tid & 63, w = tid >> 6;
    const float* rss3 = (const float*)(a.ws + OFF_RSS) + 2 * MTOK; const float* gf = a.in[20];
    for (int row = blockIdx.x * 8 + w; row < MTOK; row += gridDim.x * 8) {
        const float rstd = rsqrtf(rss3[row] * (1.0f / 1024.0f) + EPS);
        f32x4* o = (f32x4*)(a.out + (size_t)row * 1024) + lane;
#pragma unroll
        for (int j = 0; j < 4; ++j) { const f32x4 g = *((const f32x4*)gf + lane + 64 * j); f32x4 v = o[64 * j]; v = v * rstd * g; o[64 * j] = v; }
    }
}

#define XB_TMO      128
#define XB_XCNT(j)  (256  + 64 * (j))
#define XB_XSUB(j)  (1280 + 64 * (j))
#define XB_XGEN(j)  (2304 + 64 * (j))
#define XB_TOP      3328
#define XB_TOPGEN   3392
#define XCD_BAR_WORDS 3456
#define XB_SPIN_CAP (1u << 22)
DI unsigned xb_ld(unsigned* p) { return __hip_atomic_load(p, __ATOMIC_RELAXED, __HIP_MEMORY_SCOPE_AGENT); }
DI unsigned xb_add(unsigned* p, unsigned v) { return __hip_atomic_fetch_add(p, v, __ATOMIC_RELAXED, __HIP_MEMORY_SCOPE_AGENT); }
DI unsigned xb_xcc_id() { return (unsigned)__builtin_amdgcn_s_getreg((3 << 11) | 20) & 0xFu; }
#define XB_SPIN(cond, bar) do { unsigned _sp = 0; while (cond) { __builtin_amdgcn_s_sleep(1); \
    if ((++_sp & 255u) == 0u) { if (xb_ld(&(bar)[XB_TMO])) break; if (_sp > XB_SPIN_CAP) { atomicAdd(&(bar)[XB_TMO], 1u); break; } } } } while (0)
struct XcdBarrier { unsigned* bar; unsigned x; volatile LAS unsigned* st; bool leader; };
DI XcdBarrier xcd_barrier_post(unsigned* bar, volatile LAS unsigned* st) {
    XcdBarrier b; b.bar = bar; b.x = xb_xcc_id(); b.st = st; b.leader = threadIdx.x == 0;
    if (threadIdx.x == 0) (void)xb_add(&bar[XB_XCNT(b.x)], 1u);
    return b;
}
DI void xcd_barrier_complete(unsigned* bar, unsigned x, unsigned& nloc, unsigned& nx) {
    const unsigned G = gridDim.x * gridDim.y * gridDim.z;
    unsigned sum, cnt, mine, sp = 0u;
    for (;;) {
        sum = 0u; cnt = 0u; mine = 0u;
#pragma unroll
        for (unsigned j = 0; j < 16; ++j) { const unsigned c = xb_ld(&bar[XB_XCNT(j)]); sum += c; cnt += (c > 0u) ? 1u : 0u; mine = (j == x) ? c : mine; }
        if (sum == G) break;
        __builtin_amdgcn_s_sleep(1);
        if ((++sp & 255u) == 0u) { if (xb_ld(&bar[XB_TMO])) break; if (sp > XB_SPIN_CAP) { atomicAdd(&bar[XB_TMO], 1u); break; } }
    }
    nloc = mine > 0u ? mine : 1u; nx = cnt > 0u ? cnt : 1u;
}
DI void xcd_barrier(const XcdBarrier& b) {
    asm volatile("s_waitcnt vmcnt(0)" ::: "memory");
    __syncthreads();
    if (b.leader) {
        unsigned* bar = b.bar;
        __builtin_amdgcn_s_waitcnt(0);
        unsigned nloc = b.st[0], nx = b.st[1];
        if (nloc == 0u) { xcd_barrier_complete(bar, b.x, nloc, nx); b.st[0] = nloc; b.st[1] = nx; }
        const unsigned old = xb_add(&bar[XB_XSUB(b.x)], 1u);
        const unsigned gen = old / nloc;
        if (old + 1u == (gen + 1u) * nloc) {
            __builtin_amdgcn_fence(__ATOMIC_RELEASE, "agent");
            asm volatile("s_waitcnt vmcnt(0)" ::: "memory");
            const unsigned og = xb_add(&bar[XB_TOP], 1u);
            const unsigned tg = og / nx;
            if (og + 1u == (tg + 1u) * nx) xb_add(&bar[XB_TOPGEN], 1u);
            else XB_SPIN(xb_ld(&bar[XB_TOPGEN]) == tg, bar);
            __builtin_amdgcn_fence(__ATOMIC_ACQUIRE, "agent");
            xb_add(&bar[XB_XGEN(b.x)], 1u);
            asm volatile("s_waitcnt vmcnt(0)" ::: "memory");
        } else {
            XB_SPIN(xb_ld(&bar[XB_XGEN(b.x)]) == gen, bar);
            __builtin_amdgcn_fence(__ATOMIC_ACQUIRE, "agent");
            asm volatile("s_waitcnt vmcnt(0)" ::: "memory");
        }
    }
    __syncthreads();
}

__device__ unsigned g_xbar[XCD_BAR_WORDS + 64];
typedef const __attribute__((address_space(4))) Args* KArgP;
DI Args load_args() {
#if defined(__HIP_DEVICE_COMPILE__)
    KArgP p = (KArgP)__builtin_amdgcn_kernarg_segment_ptr(); asm volatile("" : "+s"(p));
    Args r;
#pragma unroll
    for (int i = 0; i < 21; ++i) r.in[i] = p->in[i];
    r.out = p->out; r.ws = p->ws; r.ph_lo = p->ph_lo; r.ph_hi = p->ph_hi; r.wv = 0; r.pad_ = 0; return r;
#else
    return Args{};
#endif
}
__global__ __launch_bounds__(512, 2) void fwd_mega(Args a_in) {
    extern __shared__ __attribute__((aligned(16))) unsigned char smem[];
    LAS unsigned char* lds = (LAS unsigned char*)smem;
    cg::grid_group grid = cg::this_grid();
    const int ph_lo = a_in.ph_lo, ph_hi = a_in.ph_hi;
    const int wv_s = __builtin_amdgcn_readfirstlane((int)(threadIdx.x >> 6));
    volatile LAS unsigned* xst = (volatile LAS unsigned*)(lds + LDS_BYTES - 16);
    if (threadIdx.x == 0) { xst[0] = 0u; xst[1] = 0u; }
    __syncthreads();
    (void)xcd_barrier_post(g_xbar, xst);
    if (ph_lo < 0) grid.sync();
#define GRID_BARRIER() do { XcdBarrier xb_; xb_.bar = g_xbar; xb_.x = xb_xcc_id(); xb_.st = (volatile LAS unsigned*)(lds + LDS_BYTES - 16); xb_.leader = (wv_s == 0) && (olane() == 0); xcd_barrier(xb_); } while (0)
#define RUN_PHASE(PH, ...) do { if (ph_lo <= (PH) && (PH) < ph_hi) { for (int rep_ = 0; rep_ < ((PROBE_PH == (PH)) ? 2 : 1); ++rep_) { { Args a = load_args(); a.wv = wv_s; unsigned char* ws = a.ws; float* rss = (float*)(ws + OFF_RSS); \
        const int G = osg((int)gridDim.x), c = osg((int)blockIdx.x); (void)ws; (void)rss; (void)G; (void)c; __VA_ARGS__ } if ((PH) + 1 < ph_hi || rep_ == 0 && PROBE_PH == (PH)) GRID_BARRIER(); } } } while (0)
    RUN_PHASE(0, phase0(a, lds););
    RUN_PHASE(1, { pg8::StaticOrder S; S.init(MTOK, NPROJ, G, c); pg8::Gemm g{(const bf16_t*)(ws + A_XN), (const bf16_t*)(ws + A_XN), (const bf16_t*)(ws + OFF_WIN), (const bf16_t*)(ws + OFF_WIN), 1024, 16, 16, a.wv};
            EpiProj E{(bf16_t*)(ws + A_PROJA), (bf16_t*)(ws + A_ZG), (float*)(ws + OFF_SMALL)}; pg8::gemm_phase(lds, g, S, E);
            if (G == 256 && c >= 192) { __syncthreads(); p0_weights(a, lds, P0_I_IN, P0_NIT, c - 192, 64); } });
    RUN_PHASE(2, phase2(a););
    RUN_PHASE(3, phase3(a, lds););
    RUN_PHASE(4, phase4(a, lds););
    RUN_PHASE(5, phase5(a););
    RUN_PHASE(6, { pg8::StaticOrder S; S.init(MTOK, 1024, G, c); pg8::Gemm g{(const bf16_t*)a.out + (size_t)3 * MTOK * 512, (const bf16_t*)(ws + A_YDN), (const bf16_t*)(ws + OFF_WAD), (const bf16_t*)(ws + OFF_WAD) + (size_t)1024 * 512, 512, 16, 8, a.wv};
            EpiMerge E{(const bf16_t*)(ws + A_ZG), (bf16_t*)(ws + A_MERGED)}; pg8::gemm_phase(lds, g, S, E); });
    RUN_PHASE(7, { pg8::StaticOrder S; S.init(MTOK, 1024, G, c); pg8::Gemm g{(const bf16_t*)(ws + A_MERGED), (const bf16_t*)(ws + A_MERGED), (const bf16_t*)(ws + OFF_WO), (const bf16_t*)(ws + OFF_WO), 1024, 16, 16, a.wv};
            if (G == 256) { EpiResidDrain<false> E{a.in[0], (bf16_t*)(ws + A_H1B), rss}; pg8::gemm_phase(lds, g, S, E); } else { EpiResid<false> E{a.in[0], (bf16_t*)(ws + A_H1B), rss}; pg8::gemm_phase(lds, g, S, E); } });
    RUN_PHASE(8, { pg8::StaticOrder S; S.init(MTOK, DFF, G, c); pg8::Gemm g{(const bf16_t*)(ws + A_H1B), (const bf16_t*)(ws + A_H1B), (const bf16_t*)(ws + OFF_W1), (const bf16_t*)(ws + OFF_W1), 1024, 16, 16, a.wv};
            EpiFF1 E{rss, (bf16_t*)(ws + A_ACT)}; pg8::gemm_phase(lds, g, S, E); });
    RUN_PHASE(9, { pg8::StaticOrder S; S.init(MTOK, 1024, G, c); pg8::Gemm g{(const bf16_t*)(ws + A_ACT), (const bf16_t*)(ws + A_ACT), (const bf16_t*)(ws + OFF_W2), (const bf16_t*)(ws + OFF_W2), 4096, 64, 64, a.wv};
            if (G == 256) { EpiResidDrain<true> E{(const void*)(ws + A_H1B), (bf16_t*)(ws + A_H2B), rss + MTOK}; pg8::gemm_phase(lds, g, S, E); } else { EpiResid<true> E{(const void*)(ws + A_H1B), (bf16_t*)(ws + A_H2B), rss + MTOK}; pg8::gemm_phase(lds, g, S, E); } });
    if (ph_lo <= 10 && 10 < ph_hi) for (int rep_ = 0; rep_ < ((PROBE_PH == 10) ? 2 : 1); ++rep_) { Args a = load_args(); a.wv = wv_s; unsigned char* ws = a.ws; const int G = osg((int)gridDim.x), c = osg((int)blockIdx.x);
        pg8::StaticOrder S; S.init(MTOK, 1024, G, c); pg8::Gemm g{(const bf16_t*)(ws + OFF_PB), (const bf16_t*)(ws + OFF_PB), (const bf16_t*)(ws + OFF_WPP), (const bf16_t*)(ws + OFF_WPP), 256, 4, 4, a.wv};
        EpiPP E{(bf16_t*)(ws + A_PP)}; pg8::gemm_phase(lds, g, S, E);
    }
    if (gridDim.x == 256) {
        if (ph_lo <= 11 && 11 < ph_hi) { Args a = load_args(); a.wv = wv_s; unsigned char* ws = a.ws; float* rss = (float*)(ws + OFF_RSS); const int G = osg((int)gridDim.x), c = osg((int)blockIdx.x);
            pg8::StaticOrder S; S.init(MTOK, 1024, G, c); pg8::Gemm g{(const bf16_t*)(ws + A_H2B), (const bf16_t*)(ws + A_H2B), (const bf16_t*)(ws + OFF_WPG), (const bf16_t*)(ws + OFF_WPG), 1024, 16, 16, a.wv};
            EpiGateFinal E{rss + MTOK, (const bf16_t*)(ws + A_PP), (const bf16_t*)(ws + A_H2B), a.out, rss + 2 * MTOK, (unsigned*)(ws + OFF_CNT), a.in[20], a.wv}; pg8::gemm_phase(lds, g, S, E); }
    } else {
        RUN_PHASE(11, { pg8::StaticOrder S; S.init(MTOK, 1024, G, c); pg8::Gemm g{(const bf16_t*)(ws + A_H2B), (const bf16_t*)(ws + A_H2B), (const bf16_t*)(ws + OFF_WPG), (const bf16_t*)(ws + OFF_WPG), 1024, 16, 16, a.wv};
                EpiGate E{rss + MTOK, (const bf16_t*)(ws + A_PP), (const bf16_t*)(ws + A_H2B), a.out, rss + 2 * MTOK}; pg8::gemm_phase(lds, g, S, E); });
        RUN_PHASE(12, phase12(a););
    }
    for (int i = 0; i < PROBE_SYNCS; ++i) GRID_BARRIER();
    __syncthreads();
    if (wv_s == 0) {
        unsigned last = 0u;
        if (olane() == 0) last = (xb_add(&g_xbar[XCD_BAR_WORDS], 1u) + 1u == gridDim.x) ? 1u : 0u;
        last = (unsigned)__builtin_amdgcn_readfirstlane((int)last);
        if (last) { for (int i = olane(); i < XCD_BAR_WORDS + 64; i += 64) __hip_atomic_store(&g_xbar[i], 0u, __ATOMIC_RELAXED, __HIP_MEMORY_SCOPE_AGENT); }
    }
}

extern "C" void kernel_launch(void* const* d_in, const int* in_sizes, int n_in, void* d_out, int out_size, void* d_ws, size_t ws_size, hipStream_t stream) {
    static int grid = 0;
    if (grid == 0) {
        if (n_in != 21 || out_size != MTOK * DM || ws_size < WS_NEED) { fprintf(stderr, "kernel_launch: unexpected shapes (n_in %d out %d ws %zu)\n", n_in, out_size, ws_size); grid = -1; return; }
        int dev = 0, cus = 0, per_cu = 0;
        (void)hipGetDevice(&dev);
        (void)hipDeviceGetAttribute(&cus, hipDeviceAttributeMultiprocessorCount, dev);
        if (hipFuncSetAttribute((const void*)fwd_mega, hipFuncAttributeMaxDynamicSharedMemorySize, LDS_BYTES) != hipSuccess) { fprintf(stderr, "kernel_launch: hipFuncSetAttribute failed\n"); grid = -1; return; }
        if (hipOccupancyMaxActiveBlocksPerMultiprocessor(&per_cu, (const void*)fwd_mega, 512, LDS_BYTES) != hipSuccess || per_cu < 1) per_cu = 1;
        (void)hipGetLastError();
        grid = cus * per_cu;
        if (grid > 256) grid = 256;
        grid &= ~7;
        if (grid < 8) grid = 8;
    }
    if (grid < 0) return;
    Args a{};
    for (int i = 0; i < 21; ++i) a.in[i] = (const float*)d_in[i];
    a.out = (float*)d_out; a.ws = (unsigned char*)d_ws;
#if MK_PER_PHASE
    for (int ph = 0; ph < NPHASE; ++ph) { a.ph_lo = ph; a.ph_hi = ph + 1; hipLaunchKernelGGL(fwd_mega, dim3(grid), dim3(512), LDS_BYTES, stream, a); }
#else
    a.ph_lo = 0; a.ph_hi = NPHASE;
    void* args[] = {&a};
    hipError_t e = hipLaunchCooperativeKernel((const void*)fwd_mega, dim3(grid), dim3(512), args, LDS_BYTES, stream);
    if (e != hipSuccess) fprintf(stderr, "cooperative launch failed: %s (grid %d)\n", hipGetErrorString(e), grid);
#endif
}
```
